# Optimizing an MI355X kernel written in HIP

```python
import math
import jax
import jax.numpy as jnp
from jax import lax
import numpy as np

D_MODEL = 2048
BATCH = 4
SEQ = 4096
DEPTH = 2

GRID_W = 64
CTX_LEN = 256
N_EVEN = (DEPTH + 1) // 2
N_ODD = DEPTH // 2
MOD_CHUNKS = 6
FFN_HIDDEN = 4 * D_MODEL
NORM_EPS = 1e-6
SCAN_CHUNK = 128

S5_WIDTH = D_MODEL // 2
S5_P = 16
S5_G = S5_WIDTH // S5_P
S5_N = 64
DT_MIN = 0.001
DT_MAX = 0.1
LAMBDA_RE_MAX = -1e-4
RET_DK = 256
RET_H = (D_MODEL // 2) // RET_DK
RET_DV = (D_MODEL // 2) // RET_H
RET_DECAY_BASE = -5.0
EVEN_IN = S5_WIDTH + 2 * RET_H * RET_DK + 2 * RET_H * RET_DV
EVEN_CAT = S5_WIDTH + RET_H * RET_DV

ATT_HD = 64
ATT_H = D_MODEL // ATT_HD
ATT_KVH = ATT_H // 8
ODD_IN = (ATT_H + 2 * ATT_KVH) * ATT_HD
WINDOW = 128
ATT_BLOCK = 128
ROPE_BASE = 10000.0
NEG_INF = -1e30

kernel_name = 'hybrid_s5_retention_swa_dit'


def rms_norm(x, g):
    xf = x.astype(jnp.float32)
    y = xf * lax.rsqrt(jnp.mean(xf * xf, axis=-1, keepdims=True) + NORM_EPS)
    return (y * g.astype(jnp.float32)).astype(x.dtype)


def head_rms(o):
    of = o.astype(jnp.float32)
    return of * lax.rsqrt(jnp.mean(of * of, axis=-1, keepdims=True) + NORM_EPS)


def ada_modulation(cvec, w, b):
    m = jax.nn.silu(cvec) @ w + b
    return jnp.split(m, MOD_CHUNKS, axis=-1)


def modulate(h, shift, scale):
    return h * (1.0 + scale[:, None, :]) + shift[:, None, :]


def gated_residual(x, out, g_post, gate):
    return x + gate[:, None, :] * rms_norm(out, g_post)


def sq_relu_mlp(h, w1, w2):
    a = jax.nn.relu(h @ w1)
    return (a * a) @ w2


def _flip(t):
    return jnp.flip(t, axis=1)


def _identity(t):
    return t


def _linear_recurrence_combine(left, right):
    a1r, a1i, b1r, b1i = left
    a2r, a2i, b2r, b2i = right
    ar = a2r * a1r - a2i * a1i
    ai = a2r * a1i + a2i * a1r
    br = a2r * b1r - a2i * b1i + b2r
    bi = a2r * b1i + a2i * b1r + b2i
    return ar, ai, br, bi


def s5_scan(u, h0, lam_re, lam_im, log_dt, b_re, b_im, c_re, c_im):
    f32 = jnp.float32
    bsz, n, g, p = u.shape
    t = SCAN_CHUNK
    nc = n // t
    lr = jnp.minimum(lam_re.astype(f32), LAMBDA_RE_MAX)
    li = lam_im.astype(f32)
    dt = jnp.exp(log_dt.astype(f32))[:, None]
    zr, zi = lr * dt, li * dt
    ab_mag = jnp.exp(zr)
    ab_re, ab_im = ab_mag * jnp.cos(zi), ab_mag * jnp.sin(zi)
    den = lr * lr + li * li
    nr = ab_re - 1.0
    f_re = (nr * lr + ab_im * li) / den
    f_im = (ab_im * lr - nr * li) / den
    br, bi = b_re.astype(f32), b_im.astype(f32)
    bb_re = f_re[..., None] * br - f_im[..., None] * bi
    bb_im = f_re[..., None] * bi + f_im[..., None] * br
    steps = jnp.arange(1, t + 1, dtype=f32)[:, None, None]
    pw_mag = jnp.exp(steps * zr)
    pw_re, pw_im = pw_mag * jnp.cos(steps * zi), pw_mag * jnp.sin(steps * zi)
    a_re = jnp.broadcast_to(ab_re, (bsz, t) + ab_re.shape)
    a_im = jnp.broadcast_to(ab_im, (bsz, t) + ab_im.shape)
    cr, ci = c_re.astype(f32), c_im.astype(f32)

    def step(h, u_c):
        hr, hi = h
        bu_re = jnp.einsum('btgp,gnp->btgn', u_c, bb_re)
        bu_im = jnp.einsum('btgp,gnp->btgn', u_c, bb_im)
        _, _, sr, si = lax.associative_scan(_linear_recurrence_combine, (a_re, a_im, bu_re, bu_im), axis=1)
        st_re = sr + pw_re * hr[:, None] - pw_im * hi[:, None]
        st_im = si + pw_re * hi[:, None] + pw_im * hr[:, None]
        y = jnp.einsum('btgn,gpn->btgp', st_re, cr) - jnp.einsum('btgn,gpn->btgp', st_im, ci)
        return (st_re[:, -1], st_im[:, -1]), y

    u_chunks = u.astype(f32).reshape(bsz, nc, t, g, p).swapaxes(0, 1)
    h_last, y = lax.scan(step, h0, u_chunks)
    return h_last, y.swapaxes(0, 1).reshape(bsz, n, g, p)


def s5_bidirectional(u_ctx, u_lat, lam_re, lam_im, log_dt, b_re, b_im, c_re, c_im):
    bsz = u_lat.shape[0]
    ys_c, ys_l = [], []
    for direction in range(2):
        rev = _flip if direction == 1 else _identity
        prm = (lam_re[direction], lam_im[direction], log_dt[direction],
               b_re[direction], b_im[direction], c_re[direction], c_im[direction])
        h0 = (jnp.zeros((bsz, S5_G, S5_N), jnp.float32), jnp.zeros((bsz, S5_G, S5_N), jnp.float32))
        h_ctx, yc = s5_scan(rev(u_ctx), h0, *prm)
        _, yl = s5_scan(rev(u_lat), h_ctx, *prm)
        ys_c.append(rev(yc))
        ys_l.append(rev(yl))
    return ys_c[0] + ys_c[1], ys_l[0] + ys_l[1]


def retention_log_decay(direction):
    e = RET_DECAY_BASE - (2.0 * jnp.arange(RET_H, dtype=jnp.float32) + direction)
    return jnp.log1p(-jnp.exp2(e))


def retention_scan(q, k, v, r0, log_g):
    f32 = jnp.float32
    bsz, n = q.shape[:2]
    t = SCAN_CHUNK
    nc = n // t
    pos = jnp.arange(t, dtype=f32)
    diff = pos[:, None] - pos[None, :]
    lower = diff >= 0
    decay_in = jnp.where(lower[None], jnp.exp(jnp.maximum(diff, 0.0)[None] * log_g[:, None, None]), 0.0)
    q_dec = jnp.exp((pos[:, None] + 1.0) * log_g[None, :])
    k_dec = jnp.exp((t - 1.0 - pos)[:, None] * log_g[None, :])
    chunk_dec = jnp.exp(t * log_g)

    def to_chunks(a):
        return a.astype(f32).reshape((bsz, nc, t) + a.shape[2:]).swapaxes(0, 1)

    def step(r, xs):
        qc, kc, vc = xs
        s = jnp.einsum('bnhd,bmhd->bhnm', qc, kc) * decay_in[None]
        inner = jnp.einsum('bhnm,bmhe->bnhe', s, vc)
        cross = jnp.einsum('bnhd,bhde->bnhe', qc, r) * q_dec[None, :, :, None]
        r_new = r * chunk_dec[None, :, None, None] + jnp.einsum('bmhd,bmhe->bhde', kc * k_dec[None, :, :, None], vc)
        return r_new, inner + cross

    r_last, o = lax.scan(step, r0, (to_chunks(q), to_chunks(k), to_chunks(v)))
    return r_last, o.swapaxes(0, 1).reshape(bsz, n, RET_H, RET_DV)


def retention_bidirectional(q_c, k_c, v_c, q_l, k_l, v_l):
    bsz = q_l.shape[0]
    os_c, os_l = [], []
    for direction in range(2):
        rev = _flip if direction == 1 else _identity
        log_g = retention_log_decay(direction)
        r0 = jnp.zeros((bsz, RET_H, RET_DK, RET_DV), jnp.float32)
        r_ctx, oc = retention_scan(rev(q_c), rev(k_c), rev(v_c), r0, log_g)
        _, ol = retention_scan(rev(q_l), rev(k_l), rev(v_l), r_ctx, log_g)
        os_c.append(rev(oc))
        os_l.append(rev(ol))
    return os_c[0] + os_c[1], os_l[0] + os_l[1]


def s5_retention_mixer(h_ctx, h_lat, w_in, w_out, lam_re, lam_im, log_dt, b_re, b_im,
                       c_re, c_im, d_skip, glu_w, glu_b, need_ctx):
    qk_w = RET_H * RET_DK
    v_w = RET_H * RET_DV
    cuts = [S5_WIDTH, S5_WIDTH + qk_w, S5_WIDTH + 2 * qk_w, S5_WIDTH + 2 * qk_w + v_w]

    def project(h):
        bsz, n, _ = h.shape
        u, q, k, v, g = jnp.split(h @ w_in, cuts, axis=-1)
        return (u, u.reshape(bsz, n, S5_G, S5_P),
                q.reshape(bsz, n, RET_H, RET_DK),
                k.reshape(bsz, n, RET_H, RET_DK) * (RET_DK ** -0.5),
                v.reshape(bsz, n, RET_H, RET_DV), g)

    u_c, u4_c, q_c, k_c, v_c, g_c = project(h_ctx)
    u_l, u4_l, q_l, k_l, v_l, g_l = project(h_lat)
    ys_c, ys_l = s5_bidirectional(u4_c, u4_l, lam_re, lam_im, log_dt, b_re, b_im, c_re, c_im)
    r_c, r_l = retention_bidirectional(q_c, k_c, v_c, q_l, k_l, v_l)

    def merge(y_s5, u, r, g):
        bsz, n = u.shape[:2]
        y = jax.nn.gelu(y_s5.reshape(bsz, n, S5_WIDTH).astype(u.dtype) + d_skip * u)
        s5_out = y * jax.nn.sigmoid(y @ glu_w + glu_b)
        ret_out = head_rms(r).reshape(bsz, n, v_w).astype(g.dtype) * jax.nn.silu(g)
        return jnp.concatenate([s5_out, ret_out], axis=-1) @ w_out

    out_l = merge(ys_l, u_l, r_l, g_l)
    out_c = merge(ys_c, u_c, r_c, g_c) if need_ctx else None
    return out_c, out_l


def axial_rope_tables(n_tokens):
    f32 = jnp.float32
    rows = n_tokens // GRID_W
    row = jnp.repeat(jnp.arange(rows, dtype=f32), GRID_W)
    col = jnp.tile(jnp.arange(GRID_W, dtype=f32), rows)
    n_freq = ATT_HD // 4
    inv_freq = ROPE_BASE ** (-jnp.arange(n_freq, dtype=f32) / n_freq)
    ang = jnp.concatenate([row[:, None] * inv_freq[None], col[:, None] * inv_freq[None]], axis=-1)
    return jnp.cos(ang), jnp.sin(ang)


def apply_rope(x, cos, sin):
    half = ATT_HD // 2
    c = cos[None, :, None, :].astype(x.dtype)
    s = sin[None, :, None, :].astype(x.dtype)
    x1, x2 = x[..., :half], x[..., half:]
    return jnp.concatenate([x1 * c - x2 * s, x2 * c + x1 * s], axis=-1)


def sink_probs(sink_kg, parts):
    lead = parts[0].shape[:-1]
    s_sink = jnp.broadcast_to(sink_kg[None, :, :, None, None], lead + (1,))
    p = jax.nn.softmax(jnp.concatenate([s_sink] + list(parts), axis=-1), axis=-1)
    return p[..., 1:]


def window_attention(h_ctx, h_lat, w_in, w_out, sink, need_ctx):
    f32 = jnp.float32
    bsz, n, _ = h_lat.shape
    n_ctx = h_ctx.shape[1]
    grp = ATT_H // ATT_KVH
    qw = ATT_H * ATT_HD
    kvw = ATT_KVH * ATT_HD
    scale = ATT_HD ** -0.5
    p_l = h_lat @ w_in
    q_l = p_l[..., :qw].reshape(bsz, n, ATT_H, ATT_HD)
    k_l = p_l[..., qw:qw + kvw].reshape(bsz, n, ATT_KVH, ATT_HD)
    v_l = p_l[..., qw + kvw:].reshape(bsz, n, ATT_KVH, ATT_HD)
    cos, sin = axial_rope_tables(n)
    q_l = (apply_rope(q_l, cos, sin) * scale).reshape(bsz, n, ATT_KVH, grp, ATT_HD)
    k_l = apply_rope(k_l, cos, sin)
    p_c = h_ctx @ (w_in if need_ctx else w_in[:, qw:])
    k_c = p_c[..., -2 * kvw:-kvw].reshape(bsz, n_ctx, ATT_KVH, ATT_HD)
    v_c = p_c[..., -kvw:].reshape(bsz, n_ctx, ATT_KVH, ATT_HD)
    sink_kg = sink.astype(f32).reshape(ATT_KVH, grp)

    t = ATT_BLOCK
    band = t + 2 * WINDOW
    pad = ((0, 0), (WINDOW, WINDOW), (0, 0), (0, 0))
    k_pad = jnp.pad(k_l, pad)
    v_pad = jnp.pad(v_l, pad)
    offs_q = jnp.arange(t)
    offs_k = jnp.arange(band)
    in_window = jnp.abs(offs_k[None, :] - WINDOW - offs_q[:, None]) <= WINDOW

    def attend_block(bi):
        start = bi * t
        qb = lax.dynamic_slice_in_dim(q_l, start, t, axis=1)
        kb = lax.dynamic_slice_in_dim(k_pad, start, band, axis=1)
        vb = lax.dynamic_slice_in_dim(v_pad, start, band, axis=1)
        kpos = start - WINDOW + offs_k
        valid = in_window & ((kpos >= 0) & (kpos < n))[None, :]
        s_ctx = jnp.einsum('btkgd,bskd->bkgts', qb, k_c).astype(f32)
        s_loc = jnp.where(valid, jnp.einsum('btkgd,bskd->bkgts', qb, kb).astype(f32), NEG_INF)
        p = sink_probs(sink_kg, [s_ctx, s_loc]).astype(vb.dtype)
        return (jnp.einsum('bkgts,bskd->btkgd', p[..., :n_ctx], v_c)
                + jnp.einsum('bkgts,bskd->btkgd', p[..., n_ctx:], vb))

    o_l = lax.map(attend_block, jnp.arange(n // t))
    out_l = o_l.swapaxes(0, 1).reshape(bsz, n, qw) @ w_out
    out_c = None
    if need_ctx:
        q_c = (p_c[..., :qw] * scale).reshape(bsz, n_ctx, ATT_KVH, grp, ATT_HD)
        s = jnp.einsum('btkgd,bskd->bkgts', q_c, k_c).astype(f32)
        p = sink_probs(sink_kg, [s]).astype(v_c.dtype)
        out_c = jnp.einsum('bkgts,bskd->btkgd', p, v_c).reshape(bsz, n_ctx, qw) @ w_out
    return out_c, out_l


def setup_inputs(seed: int = 0) -> dict:
    key = jax.random.key(seed)
    ks = jax.random.split(key, 24)
    f32 = jnp.float32
    d = D_MODEL

    def nrm(k, shape, s):
        return jax.random.normal(k, shape, f32) * s

    n_idx = jnp.arange(S5_N, dtype=f32)
    s5_shape = (N_EVEN, 2, S5_G, S5_N)
    return {
        'x': nrm(ks[0], (BATCH, SEQ, d), 1.0),
        'c': nrm(ks[1], (BATCH, d), 1.0),
        'ctx': nrm(ks[2], (BATCH, CTX_LEN, d), 1.0),
        'c_ctx': nrm(ks[3], (d,), 1.0),
        'mod_w': nrm(ks[4], (DEPTH, d, MOD_CHUNKS * d), 0.5 * d ** -0.5),
        'mod_b': nrm(ks[5], (DEPTH, MOD_CHUNKS * d), 0.02),
        'norm_g': 1.0 + nrm(ks[6], (DEPTH, 4, d), 0.05),
        'mlp_w1': nrm(ks[7], (DEPTH, d, FFN_HIDDEN), d ** -0.5),
        'mlp_w2': nrm(ks[8], (DEPTH, FFN_HIDDEN, d), FFN_HIDDEN ** -0.5),
        'even_w_in': nrm(ks[9], (N_EVEN, d, EVEN_IN), d ** -0.5),
        'even_w_out': nrm(ks[10], (N_EVEN, EVEN_CAT, d), EVEN_CAT ** -0.5),
        's5_lam_re': -0.5 + nrm(ks[11], s5_shape, 0.01),
        's5_lam_im': math.pi * n_idx + nrm(ks[12], s5_shape, 0.01),
        's5_log_dt': jax.random.uniform(ks[13], (N_EVEN, 2, S5_G), f32, math.log(DT_MIN), math.log(DT_MAX)),
        's5_b_re': nrm(ks[14], (N_EVEN, 2, S5_G, S5_N, S5_P), (2 * S5_P) ** -0.5),
        's5_b_im': nrm(ks[15], (N_EVEN, 2, S5_G, S5_N, S5_P), (2 * S5_P) ** -0.5),
        's5_c_re': nrm(ks[16], (N_EVEN, 2, S5_G, S5_P, S5_N), S5_N ** -0.5),
        's5_c_im': nrm(ks[17], (N_EVEN, 2, S5_G, S5_P, S5_N), S5_N ** -0.5),
        's5_d': nrm(ks[18], (N_EVEN, S5_WIDTH), 1.0),
        's5_glu_w': nrm(ks[19], (N_EVEN, S5_WIDTH, S5_WIDTH), S5_WIDTH ** -0.5),
        's5_glu_b': nrm(ks[20], (N_EVEN, S5_WIDTH), 0.02),
        'odd_w_in': nrm(ks[21], (N_ODD, d, ODD_IN), d ** -0.5),
        'odd_w_out': nrm(ks[22], (N_ODD, ATT_H * ATT_HD, d), (ATT_H * ATT_HD) ** -0.5),
        'odd_sink': nrm(ks[23], (N_ODD, ATT_H), 1.0),
    }


def reference(x, c, ctx, c_ctx, mod_w, mod_b, norm_g, mlp_w1, mlp_w2, even_w_in, even_w_out,
              s5_lam_re, s5_lam_im, s5_log_dt, s5_b_re, s5_b_im, s5_c_re, s5_c_im, s5_d,
              s5_glu_w, s5_glu_b, odd_w_in, odd_w_out, odd_sink):
    xc = ctx
    c_ctx_b = c_ctx[None, :]
    for i in range(DEPTH):
        last = i == DEPTH - 1
        j = i // 2
        sh1, sc1, gt1, sh2, sc2, gt2 = ada_modulation(c, mod_w[i], mod_b[i])
        csh1, csc1, cgt1, csh2, csc2, cgt2 = ada_modulation(c_ctx_b, mod_w[i], mod_b[i])
        g_pre1, g_post1, g_pre2, g_post2 = norm_g[i, 0], norm_g[i, 1], norm_g[i, 2], norm_g[i, 3]

        h_l = modulate(rms_norm(x, g_pre1), sh1, sc1)
        h_c = modulate(rms_norm(xc, g_pre1), csh1, csc1)
        if i % 2 == 0:
            o_c, o_l = s5_retention_mixer(h_c, h_l, even_w_in[j], even_w_out[j],
                                          s5_lam_re[j], s5_lam_im[j], s5_log_dt[j], s5_b_re[j], s5_b_im[j],
                                          s5_c_re[j], s5_c_im[j], s5_d[j], s5_glu_w[j], s5_glu_b[j],
                                          need_ctx=not last)
        else:
            o_c, o_l = window_attention(h_c, h_l, odd_w_in[j], odd_w_out[j], odd_sink[j], need_ctx=not last)
        x = gated_residual(x, o_l, g_post1, gt1)

        m_l = sq_relu_mlp(modulate(rms_norm(x, g_pre2), sh2, sc2), mlp_w1[i], mlp_w2[i])
        x = gated_residual(x, m_l, g_post2, gt2)

        if not last:
            xc = gated_residual(xc, o_c, g_post1, cgt1)
            m_c = sq_relu_mlp(modulate(rms_norm(xc, g_pre2), csh2, csc2), mlp_w1[i], mlp_w2[i])
            xc = gated_residual(xc, m_c, g_post2, cgt2)
    return x
```

```cpp
#include <hip/hip_runtime.h>
#include <hip/hip_cooperative_groups.h>
#include <cstdio>
#include <cstdint>
namespace cg = cooperative_groups;
namespace pg8 {
#define PG8_LAS __attribute__((address_space(3)))
typedef unsigned short bf16_t;
typedef short bf16x8 __attribute__((ext_vector_type(8)));
typedef float f32x4 __attribute__((ext_vector_type(4)));
typedef unsigned u32x4 __attribute__((ext_vector_type(4)));
constexpr int BM = 256, BK = 64, HALF = 128, HTB = HALF * BK * 2  , STAGE_BYTES = 8 * HTB, NXCD = 8, WGM = 8;

__host__ __device__ __forceinline__ int lds_byte(int r, int c) { const int st = (r >> 4) * 2 + (c >> 5), rr = r & 15, cc = c & 31, ob = rr * 64 + cc * 2; return st * 1024 + (ob ^ (((ob >> 9) & 1) << 5)); }
__host__ __device__ __forceinline__ void stage_rc(int b, int& R, int& C) { const int st = b / 1024, sb = b % 1024, swz = sb ^ (((sb >> 9) & 1) << 5); R = (st >> 1) * 16 + swz / 64; C = (st & 1) * 32 + (swz % 64) / 2; }
__host__ __device__ __forceinline__ int perm32(int rho) { const int n = rho >> 4, i = rho & 15; return 8 * (i >> 2) + 4 * n + (i & 3); }

struct Unit { int pm, pn; };
struct Gemm { const bf16_t* A; const bf16_t* Bt; int M, N, K; };

struct StaticOrder {
    int nM, nN, nwg, G, c;
    __host__ __device__ void init(int M, int N, int G_, int c_) { nM = M / BM; nN = N / BM; nwg = nM * nN; G = G_; c = c_; }
    __host__ __device__ bool next(int i, Unit& u) const {
        const long L = (long)i * G + c; if (L >= nwg) return false;
        int wgid = (int)L; { const int q = nwg / NXCD, r = nwg % NXCD, xcd = wgid % NXCD, off = wgid / NXCD; wgid = (xcd < r ? xcd * (q + 1) : r * (q + 1) + (xcd - r) * q) + off; }
        const int nig = WGM * nN, gid = wgid / nig, fm = gid * WGM, gsz = (nM - fm) < WGM ? (nM - fm) : WGM;
        u.pm = fm + ((wgid % nig) % gsz); u.pn = (wgid % nig) / gsz; return true;
    }
    __device__ __forceinline__ void a_ready(const Unit&) const {}
    __device__ __forceinline__ void done(const Unit&) const {}
};

__device__ __forceinline__ unsigned cvt_pk_bf16(float lo, float hi) { unsigned r; asm volatile("v_cvt_pk_bf16_f32 %0, %1, %2" : "=v"(r) : "v"(lo), "v"(hi)); return r; }
typedef float f32x2 __attribute__((ext_vector_type(2)));
__device__ __forceinline__ float bf_lo(unsigned w) { return __uint_as_float(w << 16); }
__device__ __forceinline__ float bf_hi(unsigned w) { return __uint_as_float(w & 0xffff0000u); }
template <int MODE> struct EpiX {
    static constexpr bool PERM = true, AFTER_DRAIN = false;
    bf16_t* O; int ldc; int sc_lo, sc_hi; float sc; const bf16_t* yg; int ldy; const float* bias;
    __device__ __forceinline__ void operator()(const f32x4 (&acc)[2][2][4][2], const Unit& u, int wr, int wc, int fr, int fq) const {
        const int row0 = u.pm * BM + wr * 64 + fr; const int colt = u.pn * BM; const int col0 = colt + wc * 32 + 8 * fq;
        float s = 1.f; if (MODE == 0) { if (colt >= sc_lo && colt < sc_hi) s = sc; }
#pragma unroll
        for (int ai = 0; ai < 2; ++ai)
#pragma unroll
            for (int m = 0; m < 4; ++m) { const int row = row0 + ai * HALF + m * 16;
#pragma unroll
                for (int bj = 0; bj < 2; ++bj) { const int col = col0 + bj * HALF; f32x4 v0 = acc[ai][bj][m][0], v1 = acc[ai][bj][m][1];
                    if (MODE == 0) { v0 = v0 * s; v1 = v1 * s; }
                    if (MODE == 1) {
#pragma unroll
                        for (int e = 0; e < 4; ++e) { float a = fmaxf(v0[e], 0.f), b = fmaxf(v1[e], 0.f); v0[e] = a * a; v1[e] = b * b; } }
                    if (MODE == 2) { const f32x4 b0 = *(const f32x4*)(bias + col), b1 = *(const f32x4*)(bias + col + 4);
                        const u32x4 y = *(const u32x4*)(yg + (size_t)row * ldy + col);
                        float yf[8] = {bf_lo(y.x), bf_hi(y.x), bf_lo(y.y), bf_hi(y.y), bf_lo(y.z), bf_hi(y.z), bf_lo(y.w), bf_hi(y.w)};
#pragma unroll
                        for (int e = 0; e < 4; ++e) { v0[e] = yf[e] / (1.f + __expf(-(v0[e] + b0[e]))); v1[e] = yf[4 + e] / (1.f + __expf(-(v1[e] + b1[e]))); } }
                    u32x4 w; w.x = cvt_pk_bf16(v0[0], v0[1]); w.y = cvt_pk_bf16(v0[2], v0[3]); w.z = cvt_pk_bf16(v1[0], v1[1]); w.w = cvt_pk_bf16(v1[2], v1[3]);
                    *(u32x4*)(O + (size_t)row * ldc + col) = w; } }
    }
};
template <class Epi, class Sched, bool ALIGN_EPI = false, bool SP2 = false>
__device__ __forceinline__ void gemm_phase(PG8_LAS unsigned char* lds, const Gemm g, const Sched& S, const Epi& E) {
    const int tid = threadIdx.x, wid = __builtin_amdgcn_readfirstlane(tid >> 6), lane = tid & 63, wr = wid >> 2, wc = wid & 3, fr = lane & 15, fq = lane >> 4;
    const int K = g.K, nt = K / BK;
    unsigned voffA[2], voffB[2];
#pragma unroll
    for (int i = 0; i < 2; ++i) { int R, C; stage_rc(tid * 16 + i * 8192, R, C); const int Rb = Epi::PERM ? ((R & ~31) + perm32(R & 31)) : R;
        voffA[i] = (unsigned)(R * K + C) * 2u; voffB[i] = (unsigned)(Rb * K + C) * 2u; }
    const size_t kstep = (size_t)(BK * 2);
    const size_t hstep = (size_t)HALF * K * 2;
    const size_t tstep = 2 * hstep;
    const unsigned ldsw = (unsigned)wid * 1024u;
    const int aoff = lds_byte(wr * 64 + fr, fq * 8), boff = lds_byte(wc * 32 + fr, fq * 8);
#define PG8_SA(b, h) (((b) * 2 + (h)) * HTB)
#define PG8_SB(b, h) ((4 + (b) * 2 + (h)) * HTB)
#define PG8_STAGE(bufoff, gbase, voff) do { _Pragma("unroll") for (int _i = 0; _i < 2; ++_i) \
        __builtin_amdgcn_global_load_lds((const unsigned*)((const char*)(gbase) + (voff)[_i]), (PG8_LAS unsigned*)(lds + (bufoff) + ldsw + _i * 8192), 16, 0, 0); } while (0)
#define PG8_LDA(dst, b, h) do { _Pragma("unroll") for (int m = 0; m < 4; ++m) _Pragma("unroll") for (int k = 0; k < 2; ++k) dst[m][k] = *(const PG8_LAS bf16x8*)(lds + PG8_SA(b, h) + aoff + m * 2048 + k * 1024); } while (0)
#define PG8_LDB(dst, b, h) do { _Pragma("unroll") for (int n = 0; n < 2; ++n) _Pragma("unroll") for (int k = 0; k < 2; ++k) dst[n][k] = *(const PG8_LAS bf16x8*)(lds + PG8_SB(b, h) + boff + n * 2048 + k * 1024); } while (0)
#define PG8_MMA(ai, bj, At, Bt) do { __builtin_amdgcn_s_setprio(1); _Pragma("unroll") for (int m = 0; m < 4; ++m) _Pragma("unroll") for (int n = 0; n < 2; ++n) _Pragma("unroll") for (int k = 0; k < 2; ++k) \
        acc[ai][bj][m][n] = __builtin_amdgcn_mfma_f32_16x16x32_bf16(Bt[n][k], At[m][k], acc[ai][bj][m][n], 0, 0, 0); __builtin_amdgcn_s_setprio(0); } while (0)
#define PG8_WAIT_V(n) asm volatile("s_waitcnt vmcnt(" #n ")" ::: "memory")
#define PG8_WAIT_L(n) asm volatile("s_waitcnt lgkmcnt(" #n ")" ::: "memory")
#define PG8_BAR __builtin_amdgcn_s_barrier()
#define PG8_SCHED __builtin_amdgcn_sched_barrier(0)
    Unit cur, nxt; int ui = 0;
    if (!S.next(0, cur)) return;
    f32x4 acc[2][2][4][2];
#pragma unroll
    for (int a = 0; a < 2; ++a)
#pragma unroll
        for (int b = 0; b < 2; ++b)
#pragma unroll
            for (int m = 0; m < 4; ++m)
#pragma unroll
                for (int n = 0; n < 2; ++n) acc[a][b][m][n] = (f32x4){0.f, 0.f, 0.f, 0.f};
    bf16x8 At[4][2], B0[2][2], B1[2][2];
    const char* cA = (const char*)g.A + (size_t)cur.pm * tstep; const char* cB = (const char*)g.Bt + (size_t)cur.pn * tstep;
    S.a_ready(cur);
    if constexpr (SP2) {
        PG8_STAGE(PG8_SB(0, 0), cB, voffB); PG8_STAGE(PG8_SB(0, 1), cB + hstep, voffB); PG8_STAGE(PG8_SA(0, 0), cA, voffA); PG8_STAGE(PG8_SA(0, 1), cA + hstep, voffA);
        if (wr == 1) PG8_BAR;
        PG8_WAIT_V(2); PG8_BAR;
        PG8_STAGE(PG8_SB(1, 0), cB + kstep, voffB); PG8_STAGE(PG8_SA(1, 0), cA + kstep, voffA); PG8_STAGE(PG8_SB(1, 1), cB + hstep + kstep, voffB);
        PG8_WAIT_V(6); PG8_BAR;
    } else {
        PG8_STAGE(PG8_SB(0, 0), cB, voffB); PG8_STAGE(PG8_SA(0, 0), cA, voffA); PG8_STAGE(PG8_SB(0, 1), cB + hstep, voffB); PG8_STAGE(PG8_SA(0, 1), cA + hstep, voffA);
        if (wr == 1) PG8_BAR;
        PG8_WAIT_V(4); PG8_BAR;
        PG8_STAGE(PG8_SB(1, 0), cB + kstep, voffB); PG8_STAGE(PG8_SA(1, 0), cA + kstep, voffA); PG8_STAGE(PG8_SB(1, 1), cB + hstep + kstep, voffB);
        PG8_WAIT_V(6); PG8_BAR;
    }
    for (;;) {
        const bool has_next = S.next(ui + 1, nxt);
        const char* nA = has_next ? (const char*)g.A + (size_t)nxt.pm * tstep : cA; const char* nB = has_next ? (const char*)g.Bt + (size_t)nxt.pn * tstep : cB;
        for (int t = 0; t < nt; t += 2) {
            const bool last = (t == nt - 2);
            const char* a1 = cA + (size_t)(t + 1) * kstep;
            const char* a2 = last ? nA : cA + (size_t)(t + 2) * kstep; const char* b2 = last ? nB : cB + (size_t)(t + 2) * kstep;
            const char* a3 = a2 + kstep; const char* b3 = b2 + kstep;
            if (last && has_next) S.a_ready(nxt);
            if constexpr (SP2) {
            PG8_LDB(B0, 0, 0); PG8_LDB(B1, 0, 1); PG8_SCHED; PG8_LDA(At, 0, 0); PG8_STAGE(PG8_SA(1, 1), a1 + hstep, voffA);
            PG8_WAIT_V(8); PG8_WAIT_L(0); PG8_BAR; PG8_MMA(0, 0, At, B0); PG8_MMA(0, 1, At, B1); PG8_BAR; PG8_SCHED;
            PG8_LDA(At, 0, 1); PG8_STAGE(PG8_SB(0, 0), b2, voffB); PG8_STAGE(PG8_SB(0, 1), b2 + hstep, voffB); PG8_STAGE(PG8_SA(0, 0), a2, voffA);
            PG8_WAIT_V(8); PG8_WAIT_L(0); PG8_BAR; PG8_MMA(1, 0, At, B0); PG8_MMA(1, 1, At, B1); PG8_BAR; PG8_SCHED;
            PG8_LDB(B0, 1, 0); PG8_LDB(B1, 1, 1); PG8_SCHED; PG8_LDA(At, 1, 0); PG8_STAGE(PG8_SA(0, 1), a2 + hstep, voffA);
            PG8_WAIT_V(8); PG8_WAIT_L(0); PG8_BAR; PG8_MMA(0, 0, At, B0); PG8_MMA(0, 1, At, B1); PG8_BAR; PG8_SCHED;
            PG8_LDA(At, 1, 1); PG8_STAGE(PG8_SB(1, 0), b3, voffB); PG8_STAGE(PG8_SB(1, 1), b3 + hstep, voffB); PG8_STAGE(PG8_SA(1, 0), a3, voffA);
            PG8_WAIT_V(8); PG8_WAIT_L(0); PG8_BAR; PG8_MMA(1, 0, At, B0); PG8_MMA(1, 1, At, B1); PG8_BAR; PG8_SCHED;
            } else {
            PG8_LDB(B0, 0, 0); PG8_SCHED; PG8_LDA(At, 0, 0); PG8_STAGE(PG8_SA(1, 1), a1 + hstep, voffA);
            PG8_WAIT_L(8); PG8_BAR; PG8_WAIT_L(0); PG8_MMA(0, 0, At, B0); PG8_BAR; PG8_SCHED;
            PG8_LDB(B1, 0, 1); PG8_STAGE(PG8_SB(0, 0), b2, voffB);
            PG8_BAR; PG8_WAIT_L(0); PG8_MMA(0, 1, At, B1); PG8_BAR;
            PG8_LDA(At, 0, 1); PG8_STAGE(PG8_SA(0, 0), a2, voffA);
            PG8_BAR; PG8_WAIT_L(0); PG8_MMA(1, 0, At, B0); PG8_BAR; PG8_SCHED;
            PG8_STAGE(PG8_SB(0, 1), b2 + hstep, voffB);
            PG8_WAIT_V(6); PG8_BAR; PG8_MMA(1, 1, At, B1); PG8_BAR;
            PG8_LDB(B0, 1, 0); PG8_SCHED; PG8_LDA(At, 1, 0); PG8_STAGE(PG8_SA(0, 1), a2 + hstep, voffA);
            PG8_WAIT_L(8); PG8_BAR; PG8_WAIT_L(0); PG8_MMA(0, 0, At, B0); PG8_BAR; PG8_SCHED;
            PG8_LDB(B1, 1, 1); PG8_STAGE(PG8_SB(1, 0), b3, voffB);
            PG8_BAR; PG8_WAIT_L(0); PG8_MMA(0, 1, At, B1); PG8_BAR;
            PG8_LDA(At, 1, 1); PG8_STAGE(PG8_SA(1, 0), a3, voffA);
            PG8_BAR; PG8_WAIT_L(0); PG8_MMA(1, 0, At, B0); PG8_BAR; PG8_SCHED;
            PG8_STAGE(PG8_SB(1, 1), b3 + hstep, voffB);
            PG8_WAIT_V(6); PG8_BAR; PG8_MMA(1, 1, At, B1); PG8_BAR;
            }
        }
        if constexpr (ALIGN_EPI) { if (wr == 0) PG8_BAR; }
        if constexpr (!Epi::AFTER_DRAIN) { E(acc, cur, wr, wc, fr, fq); S.done(cur); }
        if (!has_next) break;
#pragma unroll
        for (int a = 0; a < 2; ++a)
#pragma unroll
            for (int b = 0; b < 2; ++b)
#pragma unroll
                for (int m = 0; m < 4; ++m)
#pragma unroll
                    for (int n = 0; n < 2; ++n) acc[a][b][m][n] = (f32x4){0.f, 0.f, 0.f, 0.f};
        cur = nxt; cA = nA; cB = nB; ++ui;
        if constexpr (ALIGN_EPI) { if (wr == 1) PG8_BAR; }
    }
    PG8_WAIT_V(0);
    if constexpr (!ALIGN_EPI) { if (wr == 0) PG8_BAR; }
    PG8_BAR;
    if constexpr (Epi::AFTER_DRAIN) { E.fused(acc, cur, wr, wc, fr, fq, lds, wid, lane); S.done(cur); }
#undef PG8_SA
#undef PG8_SB
#undef PG8_STAGE
#undef PG8_LDA
#undef PG8_LDB
#undef PG8_MMA
#undef PG8_WAIT_V
#undef PG8_WAIT_L
#undef PG8_BAR
#undef PG8_SCHED
}
}
#define LAS __attribute__((address_space(3)))
typedef unsigned short bf16_t;
typedef short bf16x8 __attribute__((ext_vector_type(8)));
typedef float f32x4 __attribute__((ext_vector_type(4)));
typedef unsigned u32x4 __attribute__((ext_vector_type(4)));
typedef unsigned u32x2 __attribute__((ext_vector_type(2)));
constexpr int DM = 2048, NB = 4, SEQ = 4096, CTXL = 256, NLAT = NB * SEQ, NCTX = NB * CTXL, NTOK = NLAT + NCTX, SL = SEQ + CTXL;
constexpr int FF = 8192, EIN = 5120, OIN = 2560;
constexpr float EPS = 1e-6f;
constexpr size_t MiB = 1u << 20;
constexpr size_t WS_WIN0 = 0, WS_GLU = 20 * MiB, WS_WOUT0 = 22 * MiB, WS_W1_0 = 30 * MiB, WS_W2_0 = 62 * MiB, WS_WIN1 = 94 * MiB, WS_WOUT1 = 104 * MiB, WS_W1_1 = 112 * MiB, WS_W2_1 = 144 * MiB;
constexpr size_t WS_XN = 176 * MiB;
constexpr size_t WS_MOD = 244 * MiB, WS_ROPE = 245 * MiB, WS_S5E = 246 * MiB, WS_XC = 247 * MiB;
constexpr size_t WS_BIG = 256 * MiB;
constexpr size_t WS_P = WS_BIG, WS_VT = WS_BIG + 170 * MiB, WS_KTF = WS_BIG + 204 * MiB, WS_KTB = WS_BIG + 238 * MiB, WS_RS = WS_BIG + 272 * MiB;
constexpr size_t WS_YF = WS_BIG + 340 * MiB, WS_YB = WS_BIG + 374 * MiB, WS_YG = WS_VT;
constexpr size_t WS_O1 = WS_BIG, WS_HB = WS_BIG, WS_O2 = WS_BIG + 272 * MiB;
constexpr size_t WS_P1 = WS_BIG, WS_VT1 = WS_BIG + 88 * MiB, WS_AO = WS_BIG + 100 * MiB, WS_O1B = WS_BIG + 170 * MiB;
constexpr size_t WS_END = WS_BIG + 408 * MiB;
constexpr int LDS_BYTES = 147456;

__device__ __forceinline__ float bf2f(unsigned short h) { return __uint_as_float((unsigned)h << 16); }
__device__ __forceinline__ float bflo(unsigned w) { return __uint_as_float(w << 16); }
__device__ __forceinline__ float bfhi(unsigned w) { return __uint_as_float(w & 0xffff0000u); }
typedef float f32x2_t __attribute__((ext_vector_type(2))); typedef __bf16 bf16x2_t __attribute__((ext_vector_type(2)));
__device__ __forceinline__ unsigned pk2(float lo, float hi) { f32x2_t v = {lo, hi}; bf16x2_t b = __builtin_convertvector(v, bf16x2_t); return __builtin_bit_cast(unsigned, b); }
__device__ __forceinline__ unsigned short f2bf(float f) { return (unsigned short)(pk2(f, 0.f) & 0xffffu); }
__device__ __forceinline__ f32x4 mfma16(bf16x8 a, bf16x8 b, f32x4 c) { return __builtin_amdgcn_mfma_f32_16x16x32_bf16(a, b, c, 0, 0, 0); }
__device__ __forceinline__ bf16x8 ldfrag(const bf16_t* base, int ld, int r, int q) { return *(const bf16x8*)(base + (size_t)r * ld + 8 * q); }
__device__ __forceinline__ float wave_sum(float v) {
#pragma unroll
    for (int o = 1; o < 64; o <<= 1) v += __shfl_xor(v, o);
    return v;
}
#define LDS_WAIT() asm volatile("s_waitcnt lgkmcnt(0)" ::: "memory")
__device__ __forceinline__ int rowF(int b, int s) { return s < CTXL ? NLAT + b * CTXL + s : b * SEQ + (s - CTXL); }
__device__ __forceinline__ int rowB(int b, int s) { return s < CTXL ? NLAT + b * CTXL + (CTXL - 1 - s) : b * SEQ + (SEQ - 1 - (s - CTXL)); }
__device__ __forceinline__ float ret_lg2(int h, int dir) {
    const float x = exp2f(-5.f - 2.f * (float)h - (float)dir);
    const float l = -x * (1.f + x * (0.5f + x * (1.f / 3.f + x * (0.25f + x * (0.2f + x * (1.f / 6.f + x * (1.f / 7.f)))))));
    return l * 1.4426950408889634f;
}
__device__ __forceinline__ bf16x8 scale_frag(bf16x8 v, float s) {
    u32x4 w = __builtin_bit_cast(u32x4, v); u32x4 o;
    o.x = pk2(bflo(w.x) * s, bfhi(w.x) * s); o.y = pk2(bflo(w.y) * s, bfhi(w.y) * s); o.z = pk2(bflo(w.z) * s, bfhi(w.z) * s); o.w = pk2(bflo(w.w) * s, bfhi(w.w) * s);
    return __builtin_bit_cast(bf16x8, o);
}

struct Args {
    const float *x, *c, *ctx, *c_ctx, *mod_w, *mod_b, *norm_g, *mlp_w1, *mlp_w2, *even_w_in, *even_w_out;
    const float *lam_re, *lam_im, *log_dt, *b_re, *b_im, *c_re, *c_im, *s5_d, *glu_w, *glu_b, *odd_w_in, *odd_w_out, *odd_sink;
    float* out; unsigned char* ws;
};

__device__ __forceinline__ void phase_mod(const Args& A, float* MOD, LAS float* ldsf, int tid, int wave, int lane, int bid, int G) {
    for (int i = tid; i < 5 * DM; i += 512) { const int r = i / DM, k = i % DM; const float v = r < 4 ? A.c[r * DM + k] : A.c_ctx[k]; ldsf[i] = v / (1.f + expf(-v)); }
    __syncthreads();
    LAS float* red = ldsf + 5 * DM;
    for (int it = bid; it < 384; it += G) {
        const int L = it / 192, cc = it % 192, col = cc * 64 + lane;
        const float* w = A.mod_w + (size_t)L * DM * 12288 + col;
        float a0 = 0.f, a1 = 0.f, a2 = 0.f, a3 = 0.f, a4 = 0.f;
        const int k0 = wave * 256;
#pragma unroll 8
        for (int k = k0; k < k0 + 256; ++k) { const float wv = w[(size_t)k * 12288]; a0 += ldsf[k] * wv; a1 += ldsf[DM + k] * wv; a2 += ldsf[2 * DM + k] * wv; a3 += ldsf[3 * DM + k] * wv; a4 += ldsf[4 * DM + k] * wv; }
        red[(wave * 5 + 0) * 64 + lane] = a0; red[(wave * 5 + 1) * 64 + lane] = a1; red[(wave * 5 + 2) * 64 + lane] = a2; red[(wave * 5 + 3) * 64 + lane] = a3; red[(wave * 5 + 4) * 64 + lane] = a4;
        __syncthreads();
        if (wave == 0) {
            const float bias = A.mod_b[L * 12288 + col]; const int k6 = col / DM, cw = col % DM;
#pragma unroll
            for (int r = 0; r < 5; ++r) { float s = 0.f;
#pragma unroll
                for (int w8 = 0; w8 < 8; ++w8) s += red[(w8 * 5 + r) * 64 + lane];
                MOD[((L * 6 + k6) * 5 + r) * DM + cw] = s + bias; }
        }
        __syncthreads();
    }
}
__device__ __forceinline__ void p0_transpose_item(const float* W, int K, int N, bf16_t* WT, LAS float* scr, int item, int lane) {
    const int nblk = N / 32, kb = item / nblk, nb = item % nblk, k0 = 64 * kb, n0 = 32 * nb;
#pragma unroll 8
    for (int i = 0; i < 32; ++i) { const int kk = 2 * i + (lane >> 5); scr[kk * 33 + (lane & 31)] = W[(size_t)(k0 + kk) * N + n0 + (lane & 31)]; }
    LDS_WAIT();
    const int c = lane & 7;
#pragma unroll
    for (int j = 0; j < 4; ++j) { const int n = (lane >> 3) + 8 * j; const LAS float* s = scr + (8 * c) * 33 + n;
        u32x4 o; o.x = pk2(s[0 * 33], s[1 * 33]); o.y = pk2(s[2 * 33], s[3 * 33]); o.z = pk2(s[4 * 33], s[5 * 33]); o.w = pk2(s[6 * 33], s[7 * 33]);
        *(u32x4*)(WT + (size_t)(n0 + n) * K + k0 + 8 * c) = o; }
    LDS_WAIT();
}
__device__ __forceinline__ void phase_wconv(const Args& A, unsigned char* ws, LAS float* scr, int gw, int NGW, int lane) {
    constexpr int I0 = (DM / 64) * (EIN / 32), I1 = (1024 / 64) * (1024 / 32), I2 = (DM / 64) * (DM / 32), I3 = (DM / 64) * (FF / 32), I4 = (FF / 64) * (DM / 32), I5 = (DM / 64) * (OIN / 32);
    constexpr int NIT = I0 + I1 + I2 + 2 * I3 + 2 * I4 + I5 + I2;
    for (int it = gw; it < NIT; it += NGW) {
        int r = it;
        if (r < I0) { p0_transpose_item(A.even_w_in, DM, EIN, (bf16_t*)(ws + WS_WIN0), scr, r, lane); continue; } r -= I0;
        if (r < I1) { p0_transpose_item(A.glu_w, 1024, 1024, (bf16_t*)(ws + WS_GLU), scr, r, lane); continue; } r -= I1;
        if (r < I2) { p0_transpose_item(A.even_w_out, DM, DM, (bf16_t*)(ws + WS_WOUT0), scr, r, lane); continue; } r -= I2;
        if (r < I3) { p0_transpose_item(A.mlp_w1, DM, FF, (bf16_t*)(ws + WS_W1_0), scr, r, lane); continue; } r -= I3;
        if (r < I4) { p0_transpose_item(A.mlp_w2, FF, DM, (bf16_t*)(ws + WS_W2_0), scr, r, lane); continue; } r -= I4;
        if (r < I5) { p0_transpose_item(A.odd_w_in, DM, OIN, (bf16_t*)(ws + WS_WIN1), scr, r, lane); continue; } r -= I5;
        if (r < I2) { p0_transpose_item(A.odd_w_out, DM, DM, (bf16_t*)(ws + WS_WOUT1), scr, r, lane); continue; } r -= I2;
        if (r < I3) { p0_transpose_item(A.mlp_w1 + (size_t)DM * FF, DM, FF, (bf16_t*)(ws + WS_W1_1), scr, r, lane); continue; } r -= I3;
        p0_transpose_item(A.mlp_w2 + (size_t)DM * FF, FF, DM, (bf16_t*)(ws + WS_W2_1), scr, r, lane);
    }
}
__device__ __forceinline__ void row_pass(const float* xs, const bf16_t* orow, const float* gate, const float* gpost, float* xd,
                                         const float* gpre, const float* shift, const float* scale, bf16_t* hd, int lane) {
    f32x4 v[8];
#pragma unroll
    for (int j = 0; j < 8; ++j) v[j] = *(const f32x4*)(xs + 4 * lane + 256 * j);
    if (orow) {
        f32x4 o[8]; float ss = 0.f;
#pragma unroll
        for (int j = 0; j < 8; ++j) { const u32x2 w = *(const u32x2*)(orow + 4 * lane + 256 * j); o[j] = (f32x4){bflo(w.x), bfhi(w.x), bflo(w.y), bfhi(w.y)};
            ss += (o[j].x * o[j].x + o[j].y * o[j].y) + (o[j].z * o[j].z + o[j].w * o[j].w); }
        ss = wave_sum(ss); const float rinv = 1.0f / sqrtf(ss * (1.f / DM) + EPS);
#pragma unroll
        for (int j = 0; j < 8; ++j) { const f32x4 g = *(const f32x4*)(gate + 4 * lane + 256 * j), gp = *(const f32x4*)(gpost + 4 * lane + 256 * j); v[j] = v[j] + g * ((o[j] * rinv) * gp); }
        if (xd) {
#pragma unroll
            for (int j = 0; j < 8; ++j) *(f32x4*)(xd + 4 * lane + 256 * j) = v[j]; }
    }
    if (hd) {
        float ss = 0.f;
#pragma unroll
        for (int j = 0; j < 8; ++j) ss += (v[j].x * v[j].x + v[j].y * v[j].y) + (v[j].z * v[j].z + v[j].w * v[j].w);
        ss = wave_sum(ss); const float rinv = 1.0f / sqrtf(ss * (1.f / DM) + EPS);
#pragma unroll
        for (int j = 0; j < 8; ++j) { const int col = 4 * lane + 256 * j; const f32x4 gp = *(const f32x4*)(gpre + col), sh = *(const f32x4*)(shift + col), sc = *(const f32x4*)(scale + col);
            const f32x4 h = ((v[j] * rinv) * gp) * (sc + 1.0f) + sh; u32x2 w; w.x = pk2(h.x, h.y); w.y = pk2(h.z, h.w); *(u32x2*)(hd + col) = w; }
    }
}
__device__ __forceinline__ void tr_item(const bf16_t* src, int ld, int col0, int b, int s0, bf16_t* outbase, int mode, float lg, LAS unsigned short* scr, int lane) {
#pragma unroll
    for (int it = 0; it < 8; ++it) { const int sr = it * 8 + (lane >> 3); const int row = rowF(b, s0 + sr);
        const u32x4 v = *(const u32x4*)(src + (size_t)row * ld + col0 + 8 * (lane & 7));
        LAS unsigned* p = (LAS unsigned*)(scr + sr * 66 + 8 * (lane & 7)); p[0] = v.x; p[1] = v.y; p[2] = v.z; p[3] = v.w; }
    LDS_WAIT();
#pragma unroll
    for (int it = 0; it < 8; ++it) { const int j = it * 8 + (lane >> 3), sc0 = 8 * (lane & 7); float f[8];
#pragma unroll
        for (int k = 0; k < 8; ++k) f[k] = bf2f(scr[(sc0 + k) * 66 + j]);
        if (mode) {
#pragma unroll
            for (int k = 0; k < 8; ++k) { const int i = (s0 + sc0 + k) & 255; const float e = mode == 1 ? (float)(255 - i) : (float)i; f[k] *= exp2f(e * lg); } }
        u32x4 o; o.x = pk2(f[0], f[1]); o.y = pk2(f[2], f[3]); o.z = pk2(f[4], f[5]); o.w = pk2(f[6], f[7]);
        *(u32x4*)(outbase + (size_t)j * SL + s0 + sc0) = o; }
    LDS_WAIT();
}
__device__ __forceinline__ size_t rs_slot(int b, int h, int dir, int pc) { return (size_t)((((b * 4 + h) * 2 + dir) * 17 + pc)) * 65536; }
__device__ __forceinline__ void ret_kv_tile(const bf16_t* Kt, const bf16_t* Vt, bf16_t* RSo, int dt, int et, int lane) {
    const int r = lane & 15, q = lane >> 4;
    f32x4 acc[4][4];
#pragma unroll
    for (int a = 0; a < 4; ++a)
#pragma unroll
        for (int b = 0; b < 4; ++b) acc[a][b] = (f32x4){0.f, 0.f, 0.f, 0.f};
    const bf16_t* Ap = Kt + (size_t)(64 * dt) * SL; const bf16_t* Bp = Vt + (size_t)(64 * et) * SL;
    for (int ks = 0; ks < 8; ++ks) {
        bf16x8 af[4], bfr[4];
#pragma unroll
        for (int t = 0; t < 4; ++t) { af[t] = ldfrag(Ap + (size_t)(16 * t) * SL + 32 * ks, SL, r, q); bfr[t] = ldfrag(Bp + (size_t)(16 * t) * SL + 32 * ks, SL, r, q); }
#pragma unroll
        for (int a = 0; a < 4; ++a)
#pragma unroll
            for (int b = 0; b < 4; ++b) acc[a][b] = mfma16(af[a], bfr[b], acc[a][b]);
    }
#pragma unroll
    for (int a = 0; a < 4; ++a)
#pragma unroll
        for (int b = 0; b < 4; ++b) { u32x2 w; w.x = pk2(acc[a][b][0], acc[a][b][1]); w.y = pk2(acc[a][b][2], acc[a][b][3]);
            *(u32x2*)(RSo + (size_t)(64 * et + 16 * b + r) * 256 + 64 * dt + 16 * a + 4 * q) = w; }
}
__device__ __forceinline__ void ret_out_tile(int b, int h, int c, int nt, const bf16_t* P, const bf16_t* VT, const bf16_t* RS, bf16_t* CAT, int lane) {
    const int r = lane & 15, q = lane >> 4;
    const int row0 = rowF(b, 256 * c);
    const bf16_t* Qp = P + (size_t)(row0 + 16 * nt) * EIN + 1024 + h * 256;
    const float in = (float)(16 * nt + r);
    const float lgf = ret_lg2(h, 0), lgb = ret_lg2(h, 1);
    f32x4 O[16];
#pragma unroll
    for (int e = 0; e < 16; ++e) O[e] = (f32x4){0.f, 0.f, 0.f, 0.f};
    const int pcf = c, pcb = (c == 0) ? 0 : 17 - c;
#pragma unroll 1
    for (int dir = 0; dir < 2; ++dir) {
        const int pc = dir ? pcb : pcf;
        if (pc == 0) continue;
        const float sf = dir ? exp2f((256.f - in) * lgb) : exp2f((in + 1.f) * lgf);
        const bf16_t* R = RS + rs_slot(b, h, dir, pc);
#pragma unroll
        for (int ks = 0; ks < 8; ++ks) { const bf16x8 Qs = scale_frag(ldfrag(Qp + 32 * ks, EIN, r, q), sf);
#pragma unroll
            for (int et = 0; et < 16; ++et) O[et] = mfma16(ldfrag(R + (size_t)(16 * et) * 256 + 32 * ks, 256, r, q), Qs, O[et]);
            __builtin_amdgcn_sched_barrier(0); }
    }
    const bf16_t* Kp = P + (size_t)row0 * EIN + 2048 + h * 256;
    const bf16_t* Vp = VT + (size_t)((b * 4 + h) * 256) * SL + 256 * c;
#pragma unroll 1
    for (int kp = 0; kp < 8; ++kp) {
        const int m0 = 32 * kp;
        f32x4 S0 = (f32x4){0.f, 0.f, 0.f, 0.f}, S1 = S0;
#pragma unroll
        for (int ks = 0; ks < 8; ++ks) { const bf16x8 qf = ldfrag(Qp + 32 * ks, EIN, r, q); S0 = mfma16(ldfrag(Kp + (size_t)m0 * EIN + 32 * ks, EIN, r, q), qf, S0); S1 = mfma16(ldfrag(Kp + (size_t)(m0 + 16) * EIN + 32 * ks, EIN, r, q), qf, S1); }
        float p0[4], p1[4];
#pragma unroll
        for (int i = 0; i < 4; ++i) { const float d0 = in - (float)(m0 + 4 * q + i), d1 = d0 - 16.f;
            const float w0 = (d0 >= 0.f ? exp2f(d0 * lgf) : 0.f) + (d0 <= 0.f ? exp2f(-d0 * lgb) : 0.f);
            const float w1 = (d1 >= 0.f ? exp2f(d1 * lgf) : 0.f) + (d1 <= 0.f ? exp2f(-d1 * lgb) : 0.f);
            p0[i] = S0[i] * w0; p1[i] = S1[i] * w1; }
        u32x4 pw; pw.x = pk2(p0[0], p0[1]); pw.y = pk2(p0[2], p0[3]); pw.z = pk2(p1[0], p1[1]); pw.w = pk2(p1[2], p1[3]);
        const bf16x8 pb = __builtin_bit_cast(bf16x8, pw);
#pragma unroll
        for (int et = 0; et < 16; ++et) { const bf16_t* vr = Vp + (size_t)(16 * et + r) * SL + m0 + 4 * q;
            const u32x2 lo = *(const u32x2*)vr, hi = *(const u32x2*)(vr + 16); u32x4 aw; aw.x = lo.x; aw.y = lo.y; aw.z = hi.x; aw.w = hi.y;
            O[et] = mfma16(__builtin_bit_cast(bf16x8, aw), pb, O[et]); }
    }
    float ss = 0.f;
#pragma unroll
    for (int e = 0; e < 16; ++e) ss += (O[e][0] * O[e][0] + O[e][1] * O[e][1]) + (O[e][2] * O[e][2] + O[e][3] * O[e][3]);
    ss += __shfl_xor(ss, 16); ss += __shfl_xor(ss, 32);
    const float rinv = 1.0f / sqrtf(ss * (1.f / 256.f) + EPS);
    const int row = row0 + 16 * nt + r;
#pragma unroll
    for (int et = 0; et < 16; ++et) { const int col = 16 * et + 4 * q; const u32x2 gw = *(const u32x2*)(P + (size_t)row * EIN + 4096 + h * 256 + col);
        const float g0 = bflo(gw.x), g1 = bfhi(gw.x), g2 = bflo(gw.y), g3 = bfhi(gw.y);
        const float o0 = O[et][0] * rinv * (g0 / (1.f + __expf(-g0))), o1 = O[et][1] * rinv * (g1 / (1.f + __expf(-g1)));
        const float o2 = O[et][2] * rinv * (g2 / (1.f + __expf(-g2))), o3 = O[et][3] * rinv * (g3 / (1.f + __expf(-g3)));
        u32x2 w; w.x = pk2(o0, o1); w.y = pk2(o2, o3); *(u32x2*)(CAT + (size_t)row * DM + 1024 + h * 256 + col) = w; }
}
constexpr int S5_NSEG = 4, S5_LSEG = SL / S5_NSEG;
template <bool EMIT>
__device__ __forceinline__ void s5_scan(const Args& A, int b, int g, int dir, int seg, const bf16_t* P, float* E, bf16_t* Y, LAS unsigned char* scr, int lane) {
    const int n = lane, r = lane & 15, q = lane >> 4;
    const int pg = dir * 64 + g;
    const float lr = fminf(A.lam_re[pg * 64 + n], -1e-4f), li = A.lam_im[pg * 64 + n], dt = expf(A.log_dt[pg]);
    const float zr = lr * dt, zi = li * dt, mag = expf(zr);
    float sn, cs; sincosf(zi, &sn, &cs);
    const float ar = mag * cs, ai = mag * sn, den = lr * lr + li * li, nr = ar - 1.f;
    const float fre = (nr * lr + ai * li) / den, fim = (ai * lr - nr * li) / den;
    LAS float* BU = (LAS float*)scr; LAS unsigned short* Sb = (LAS unsigned short*)(scr + 8448); LAS unsigned short* Bc = (LAS unsigned short*)scr;
    {
        const float* br = A.b_re + (size_t)(pg * 64 + n) * 16; const float* bi = A.b_im + (size_t)(pg * 64 + n) * 16;
#pragma unroll
        for (int p = 0; p < 16; ++p) { const float x = br[p], y = bi[p]; Bc[n * 16 + p] = f2bf(fre * x - fim * y); Bc[(64 + n) * 16 + p] = f2bf(fre * y + fim * x); }
    }
    LDS_WAIT();
    bf16x8 Bf[8];
    const bf16x8 zero8 = (bf16x8){0, 0, 0, 0, 0, 0, 0, 0};
#pragma unroll
    for (int jt = 0; jt < 8; ++jt) Bf[jt] = q < 2 ? *(const LAS bf16x8*)(Bc + (16 * jt + r) * 16 + 8 * q) : zero8;
    LDS_WAIT();
    bf16x8 Cf[4];
    if (EMIT) {
#pragma unroll
        for (int ks = 0; ks < 4; ++ks) { const int j0 = 32 * ks + 8 * q; const bool im = j0 >= 64; const float* cp = (im ? A.c_im : A.c_re) + (size_t)(pg * 16 + r) * 64 + (j0 & 63); const float sg = im ? -1.f : 1.f;
            const f32x4 c0 = *(const f32x4*)cp, c1 = *(const f32x4*)(cp + 4); u32x4 w; w.x = pk2(sg * c0.x, sg * c0.y); w.y = pk2(sg * c0.z, sg * c0.w); w.z = pk2(sg * c1.x, sg * c1.y); w.w = pk2(sg * c1.z, sg * c1.w);
            Cf[ks] = __builtin_bit_cast(bf16x8, w); }
    }
    float hr = 0.f, hi = 0.f;
    const int ubase = ((b * 64 + g) * 2 + dir) * S5_NSEG;
    if (EMIT && seg > 0) {
        float pr = 1.f, pi = 0.f, xr = ar, xi = ai; int e = S5_LSEG;
        while (e) { if (e & 1) { const float t = pr * xr - pi * xi; pi = pr * xi + pi * xr; pr = t; } const float t2 = xr * xr - xi * xi; xi = 2.f * xr * xi; xr = t2; e >>= 1; }
        for (int s2 = 0; s2 < seg; ++s2) { const float er = E[(size_t)(ubase + s2) * 128 + n], ei = E[(size_t)(ubase + s2) * 128 + 64 + n];
            const float t = pr * hr - pi * hi + er; hi = pr * hi + pi * hr + ei; hr = t; }
    }
    const int sbeg = seg * S5_LSEG;
#pragma unroll 1
    for (int sc = 0; sc < S5_LSEG / 16; ++sc) {
        const int s0 = sbeg + 16 * sc;
        const int rowr = dir ? rowB(b, s0 + r) : rowF(b, s0 + r);
        const bf16x8 uf = q < 2 ? *(const bf16x8*)(P + (size_t)rowr * EIN + g * 16 + 8 * q) : zero8;
#pragma unroll
        for (int jt = 0; jt < 8; ++jt) { const f32x4 D = mfma16(uf, Bf[jt], (f32x4){0.f, 0.f, 0.f, 0.f});
#pragma unroll
            for (int i = 0; i < 4; ++i) BU[(4 * q + i) * 132 + 16 * jt + r] = D[i]; }
        LDS_WAIT();
#pragma unroll
        for (int tt = 0; tt < 16; ++tt) { const float bur = BU[tt * 132 + n], bui = BU[tt * 132 + 64 + n];
            const float nhr = ar * hr - ai * hi + bur, nhi = ar * hi + ai * hr + bui; hr = nhr; hi = nhi;
            if (EMIT) { Sb[tt * 136 + n] = f2bf(hr); Sb[tt * 136 + 64 + n] = f2bf(hi); } }
        if (EMIT) {
            LDS_WAIT();
            f32x4 Yv = (f32x4){0.f, 0.f, 0.f, 0.f};
#pragma unroll
            for (int ks = 0; ks < 4; ++ks) Yv = mfma16(*(const LAS bf16x8*)(Sb + r * 136 + 32 * ks + 8 * q), Cf[ks], Yv);
#pragma unroll
            for (int i = 0; i < 4; ++i) { const int rw = dir ? rowB(b, s0 + 4 * q + i) : rowF(b, s0 + 4 * q + i); Y[(size_t)rw * 1024 + g * 16 + r] = f2bf(Yv[i]); }
        }
        LDS_WAIT();
    }
    if (!EMIT) { E[(size_t)(ubase + seg) * 128 + n] = hr; E[(size_t)(ubase + seg) * 128 + 64 + n] = hi; }
}
__device__ __forceinline__ float gelu_tanh(float x) { const float z = 0.7978845608028654f * (x + 0.044715f * x * x * x); const float t = 1.f - 2.f / (__expf(2.f * z) + 1.f); return 0.5f * x * (1.f + t); }
__device__ __forceinline__ void attn_unit(int b, int h, int n0, const bf16_t* P1, const bf16_t* VT1, const float* sink, bf16_t* AO, int lane) {
    const int r = lane & 15, q = lane >> 4, kvh = h >> 3;
    bf16x8 Qb[2][2];
#pragma unroll
    for (int nt = 0; nt < 2; ++nt)
#pragma unroll
        for (int ks = 0; ks < 2; ++ks) Qb[nt][ks] = ldfrag(P1 + (size_t)(b * SEQ + n0 + 16 * nt) * OIN + h * 64 + 32 * ks, OIN, r, q);
    const float snk = sink[h];
    float mrun[2] = {snk, snk}, lpart[2] = {0.f, 0.f};
    f32x4 O[2][4];
#pragma unroll
    for (int nt = 0; nt < 2; ++nt)
#pragma unroll
        for (int et = 0; et < 4; ++et) O[nt][et] = (f32x4){0.f, 0.f, 0.f, 0.f};
    const bf16_t* Vb = VT1 + (size_t)((b * 4 + kvh) * 64) * SL;
#pragma unroll 1
    for (int pr = 0; pr < 17; ++pr) {
        const bool loc = pr >= 8;
        const int m0 = loc ? n0 - 128 + 32 * (pr - 8) : 32 * pr;
        bf16x8 Kf[2][2];
#pragma unroll
        for (int kt = 0; kt < 2; ++kt) { int key = m0 + 16 * kt + r; int grow;
            if (loc) { key = key < 0 ? 0 : (key > SEQ - 1 ? SEQ - 1 : key); grow = b * SEQ + key; } else grow = NLAT + b * CTXL + key;
#pragma unroll
            for (int ks = 0; ks < 2; ++ks) Kf[kt][ks] = *(const bf16x8*)(P1 + (size_t)grow * OIN + 2048 + kvh * 64 + 32 * ks + 8 * q); }
        const int spos = loc ? CTXL + m0 : m0;
        bf16x8 Vf[4];
#pragma unroll
        for (int et = 0; et < 4; ++et) { const bf16_t* vr = Vb + (size_t)(16 * et + r) * SL + spos + 4 * q; const u32x2 lo = *(const u32x2*)vr, hi = *(const u32x2*)(vr + 16);
            u32x4 aw; aw.x = lo.x; aw.y = lo.y; aw.z = hi.x; aw.w = hi.y; Vf[et] = __builtin_bit_cast(bf16x8, aw); }
#pragma unroll
        for (int nt = 0; nt < 2; ++nt) {
            f32x4 S[2];
#pragma unroll
            for (int kt = 0; kt < 2; ++kt) { S[kt] = mfma16(Kf[kt][0], Qb[nt][0], (f32x4){0.f, 0.f, 0.f, 0.f}); S[kt] = mfma16(Kf[kt][1], Qb[nt][1], S[kt]); }
            if (loc) { const int qn = n0 + 16 * nt + r;
#pragma unroll
                for (int kt = 0; kt < 2; ++kt)
#pragma unroll
                    for (int i = 0; i < 4; ++i) { const int key = m0 + 16 * kt + 4 * q + i; const int d = key - qn; const bool ok = (d <= 128) && (d >= -128) && (key >= 0) && (key < SEQ); S[kt][i] = ok ? S[kt][i] : -1e30f; } }
            float tm = fmaxf(fmaxf(fmaxf(S[0][0], S[0][1]), fmaxf(S[0][2], S[0][3])), fmaxf(fmaxf(S[1][0], S[1][1]), fmaxf(S[1][2], S[1][3])));
            tm = fmaxf(tm, __shfl_xor(tm, 16)); tm = fmaxf(tm, __shfl_xor(tm, 32));
            const float mn = fmaxf(mrun[nt], tm), f = __expf(mrun[nt] - mn); mrun[nt] = mn;
            float p[8]; float ps = 0.f;
#pragma unroll
            for (int kt = 0; kt < 2; ++kt)
#pragma unroll
                for (int i = 0; i < 4; ++i) { p[kt * 4 + i] = __expf(S[kt][i] - mn); ps += p[kt * 4 + i]; }
            lpart[nt] = lpart[nt] * f + ps;
            u32x4 pw; pw.x = pk2(p[0], p[1]); pw.y = pk2(p[2], p[3]); pw.z = pk2(p[4], p[5]); pw.w = pk2(p[6], p[7]);
            const bf16x8 pb = __builtin_bit_cast(bf16x8, pw);
#pragma unroll
            for (int et = 0; et < 4; ++et) { O[nt][et] = O[nt][et] * f; O[nt][et] = mfma16(Vf[et], pb, O[nt][et]); }
        }
    }
#pragma unroll
    for (int nt = 0; nt < 2; ++nt) {
        float l = lpart[nt]; l += __shfl_xor(l, 16); l += __shfl_xor(l, 32); l += __expf(snk - mrun[nt]);
        const float rl = 1.f / l; const int row = b * SEQ + n0 + 16 * nt + r;
#pragma unroll
        for (int et = 0; et < 4; ++et) { u32x2 w; w.x = pk2(O[nt][et][0] * rl, O[nt][et][1] * rl); w.y = pk2(O[nt][et][2] * rl, O[nt][et][3] * rl);
            *(u32x2*)(AO + (size_t)row * DM + h * 64 + 16 * et + 4 * q) = w; }
    }
}
__global__ void __launch_bounds__(512, 2) fwd_megakernel(Args A) {
    extern __shared__ __attribute__((aligned(16))) unsigned char lds_raw[];
    cg::grid_group grid = cg::this_grid();
    LAS unsigned char* lds = (LAS unsigned char*)lds_raw;
    const int tid = threadIdx.x, lane = tid & 63, wave = __builtin_amdgcn_readfirstlane(tid >> 6);
    const int bid = blockIdx.x, G = gridDim.x;
    const int gw = bid * 8 + wave, NGW = G * 8;
    const int gtid = bid * 512 + tid, NGT = G * 512;
    unsigned char* ws = A.ws;
    float* MOD = (float*)(ws + WS_MOD); float* ROPE = (float*)(ws + WS_ROPE); float* S5E = (float*)(ws + WS_S5E); float* XC = (float*)(ws + WS_XC);
    bf16_t* XN = (bf16_t*)(ws + WS_XN);
    bf16_t* P = (bf16_t*)(ws + WS_P); bf16_t* VT = (bf16_t*)(ws + WS_VT); bf16_t* KTF = (bf16_t*)(ws + WS_KTF); bf16_t* KTB = (bf16_t*)(ws + WS_KTB); bf16_t* RS = (bf16_t*)(ws + WS_RS);
    bf16_t* YF = (bf16_t*)(ws + WS_YF); bf16_t* YB = (bf16_t*)(ws + WS_YB); bf16_t* YG = (bf16_t*)(ws + WS_YG);
    bf16_t* O1 = (bf16_t*)(ws + WS_O1); bf16_t* HB = (bf16_t*)(ws + WS_HB); bf16_t* O2 = (bf16_t*)(ws + WS_O2);
    bf16_t* P1 = (bf16_t*)(ws + WS_P1); bf16_t* VT1 = (bf16_t*)(ws + WS_VT1); bf16_t* AO = (bf16_t*)(ws + WS_AO); bf16_t* O1B = (bf16_t*)(ws + WS_O1B);
    LAS unsigned char* wscr = lds + wave * 16384;
#define GSYNC() do { asm volatile("s_waitcnt vmcnt(0) lgkmcnt(0)" ::: "memory"); grid.sync(); } while (0)
#define MODV(L, k6, r) (MOD + (((L) * 6 + (k6)) * 5 + (r)) * DM)
#define NG(L, k) (A.norm_g + ((L) * 4 + (k)) * DM)
#define GEMM(MODE, Aptr, Bptr, Mv, Nv, Kv, Optr, ldcv, lo, hi, scv, ygp, ldyv, biasp) do { \
        pg8::Gemm g_{(const bf16_t*)(Aptr), (const bf16_t*)(Bptr), (Mv), (Nv), (Kv)}; pg8::StaticOrder S_; S_.init((Mv), (Nv), G, bid); \
        pg8::EpiX<MODE> E_{(Optr), (ldcv), (lo), (hi), (scv), (ygp), (ldyv), (biasp)}; \
        pg8::gemm_phase<pg8::EpiX<MODE>, pg8::StaticOrder, true, true>(lds, g_, S_, E_); } while (0)

    phase_mod(A, MOD, (LAS float*)lds, tid, wave, lane, bid, G);
    phase_wconv(A, ws, (LAS float*)wscr, gw, NGW, lane);
    for (int i = gtid; i < 1024; i += NGT) { const int pos = i >> 4, f = i & 15; const float inv = exp2f(-(float)f * (13.287712379549449f / 16.f)); float sn, cs; sincosf((float)pos * inv, &sn, &cs); ROPE[2 * i] = cs; ROPE[2 * i + 1] = sn; }
    GSYNC();
    for (int row = gw; row < NTOK; row += NGW) { const int mr = row < NLAT ? row / SEQ : 4; const float* xs = row < NLAT ? A.x + (size_t)row * DM : A.ctx + (size_t)(row - NLAT) * DM;
        row_pass(xs, nullptr, nullptr, nullptr, nullptr, NG(0, 0), MODV(0, 0, mr), MODV(0, 1, mr), XN + (size_t)row * DM, lane); }
    GSYNC();
    GEMM(0, XN, ws + WS_WIN0, NTOK, EIN, DM, P, EIN, 2048, 3072, 0.0625f, nullptr, 0, nullptr);
    GSYNC();
    for (int it = gw; it < NB * 3 * 16 * 68; it += NGW) { int t = it; const int sc = t % 68; t /= 68; const int cb = t % 16; t /= 16; const int which = t % 3; const int b = t / 3; const int h = cb >> 2;
        bf16_t* ob = (which == 0 ? VT : which == 1 ? KTF : KTB) + (size_t)(b * 1024 + 64 * cb) * SL;
        tr_item(P, EIN, (which == 0 ? 3072 : 2048) + 64 * cb, b, 64 * sc, ob, which, which == 1 ? ret_lg2(h, 0) : ret_lg2(h, 1), (LAS unsigned short*)wscr, lane); }
    for (int vb = bid; vb < 256; vb += G) { const int seg = vb & 3, dir = (vb >> 2) & 1, b = (vb >> 3) & 3, g = (vb >> 5) * 8 + wave;
        s5_scan<false>(A, b, g, dir, seg, P, S5E, nullptr, wscr, lane); }
    GSYNC();
    for (int it = gw; it < 512 * 16; it += NGW) { int t = it; const int tt = t % 16; t /= 16; const int pc = t % 16; t /= 16; const int dir = t % 2; t /= 2; const int h = t % 4; const int b = t / 4;
        const int c = dir ? (pc == 0 ? 0 : 17 - pc) : pc;
        ret_kv_tile((dir ? KTB : KTF) + (size_t)((b * 4 + h) * 256) * SL + 256 * c, VT + (size_t)((b * 4 + h) * 256) * SL + 256 * c, RS + rs_slot(b, h, dir, pc), tt >> 2, tt & 3, lane); }
    GSYNC();
    for (int i = gtid; i < 32 * 8192; i += NGT) { const int bhd = i >> 13, e8 = (i & 8191) * 8; const int h = (bhd >> 1) & 3, dir = bhd & 1;
        const float gT = exp2f(256.f * ret_lg2(h, dir)); bf16_t* base = RS + (size_t)bhd * 17 * 65536 + e8;
        float run[8] = {0.f, 0.f, 0.f, 0.f, 0.f, 0.f, 0.f, 0.f};
        for (int pc = 0; pc < 17; ++pc) { u32x4 w = (u32x4){0u, 0u, 0u, 0u}; if (pc < 16) w = *(const u32x4*)(base + (size_t)pc * 65536);
            u32x4 o; o.x = pk2(run[0], run[1]); o.y = pk2(run[2], run[3]); o.z = pk2(run[4], run[5]); o.w = pk2(run[6], run[7]); *(u32x4*)(base + (size_t)pc * 65536) = o;
            run[0] = gT * run[0] + bflo(w.x); run[1] = gT * run[1] + bfhi(w.x); run[2] = gT * run[2] + bflo(w.y); run[3] = gT * run[3] + bfhi(w.y);
            run[4] = gT * run[4] + bflo(w.z); run[5] = gT * run[5] + bfhi(w.z); run[6] = gT * run[6] + bflo(w.w); run[7] = gT * run[7] + bfhi(w.w); } }
    GSYNC();
    for (int it = gw; it < NB * 4 * 17 * 16; it += NGW) { int t = it; const int nt = t % 16; t /= 16; const int c = t % 17; t /= 17; const int h = t % 4; const int b = t / 4;
        ret_out_tile(b, h, c, nt, P, VT, RS, XN, lane); }
    for (int vb = bid; vb < 256; vb += G) { const int seg = vb & 3, dir = (vb >> 2) & 1, b = (vb >> 3) & 3, g = (vb >> 5) * 8 + wave;
        s5_scan<true>(A, b, g, dir, seg, P, S5E, dir ? YB : YF, wscr, lane); }
    GSYNC();
    for (int i = gtid; i < NTOK * 128; i += NGT) { const int row = i >> 7, col = (i & 127) * 8;
        const u32x4 a = *(const u32x4*)(YF + (size_t)row * 1024 + col), bq = *(const u32x4*)(YB + (size_t)row * 1024 + col), u = *(const u32x4*)(P + (size_t)row * EIN + col);
        const f32x4 d0 = *(const f32x4*)(A.s5_d + col), d1 = *(const f32x4*)(A.s5_d + col + 4);
        float v[8] = {bflo(a.x) + bflo(bq.x) + d0.x * bflo(u.x), bfhi(a.x) + bfhi(bq.x) + d0.y * bfhi(u.x), bflo(a.y) + bflo(bq.y) + d0.z * bflo(u.y), bfhi(a.y) + bfhi(bq.y) + d0.w * bfhi(u.y),
                      bflo(a.z) + bflo(bq.z) + d1.x * bflo(u.z), bfhi(a.z) + bfhi(bq.z) + d1.y * bfhi(u.z), bflo(a.w) + bflo(bq.w) + d1.z * bflo(u.w), bfhi(a.w) + bfhi(bq.w) + d1.w * bfhi(u.w)};
        u32x4 o; o.x = pk2(gelu_tanh(v[0]), gelu_tanh(v[1])); o.y = pk2(gelu_tanh(v[2]), gelu_tanh(v[3])); o.z = pk2(gelu_tanh(v[4]), gelu_tanh(v[5])); o.w = pk2(gelu_tanh(v[6]), gelu_tanh(v[7]));
        *(u32x4*)(YG + (size_t)row * 1024 + col) = o; }
    GSYNC();
    GEMM(2, YG, ws + WS_GLU, NTOK, 1024, 1024, XN, DM, 0, 0, 1.f, YG, 1024, A.glu_b);
    GSYNC();
    GEMM(0, XN, ws + WS_WOUT0, NTOK, DM, DM, O1, DM, 0, 0, 1.f, nullptr, 0, nullptr);
    GSYNC();
    for (int row = gw; row < NTOK; row += NGW) { const int mr = row < NLAT ? row / SEQ : 4; const float* xs = row < NLAT ? A.x + (size_t)row * DM : A.ctx + (size_t)(row - NLAT) * DM;
        float* xd = row < NLAT ? A.out + (size_t)row * DM : XC + (size_t)(row - NLAT) * DM;
        row_pass(xs, O1 + (size_t)row * DM, MODV(0, 2, mr), NG(0, 1), xd, NG(0, 2), MODV(0, 3, mr), MODV(0, 4, mr), XN + (size_t)row * DM, lane); }
    GSYNC();
    GEMM(1, XN, ws + WS_W1_0, NTOK, FF, DM, HB, FF, 0, 0, 1.f, nullptr, 0, nullptr);
    GSYNC();
    GEMM(0, HB, ws + WS_W2_0, NTOK, DM, FF, O2, DM, 0, 0, 1.f, nullptr, 0, nullptr);
    GSYNC();
    for (int row = gw; row < NTOK; row += NGW) { const int mr = row < NLAT ? row / SEQ : 4; float* xd = row < NLAT ? A.out + (size_t)row * DM : XC + (size_t)(row - NLAT) * DM;
        row_pass(xd, O2 + (size_t)row * DM, MODV(0, 5, mr), NG(0, 3), xd, NG(1, 0), MODV(1, 0, mr), MODV(1, 1, mr), XN + (size_t)row * DM, lane); }
    GSYNC();
    GEMM(0, XN, ws + WS_WIN1, NTOK, OIN, DM, P1, OIN, 0, 0, 1.f, nullptr, 0, nullptr);
    GSYNC();
    for (int i = gtid; i < NLAT * 36 * 4; i += NGT) { const int j8 = (i & 3) * 8; int t = i >> 2; const int hd = t % 36; const int row = t / 36; const int tok = row & (SEQ - 1);
        const int pos = j8 < 16 ? (tok >> 6) : (tok & 63); const int f0 = j8 & 15; const float qs = hd < 32 ? 0.125f : 1.f;
        bf16_t* p = P1 + (size_t)row * OIN + hd * 64 + j8;
        const u32x4 a = *(const u32x4*)p, c2 = *(const u32x4*)(p + 32);
        const float x1[8] = {bflo(a.x), bfhi(a.x), bflo(a.y), bfhi(a.y), bflo(a.z), bfhi(a.z), bflo(a.w), bfhi(a.w)};
        const float x2[8] = {bflo(c2.x), bfhi(c2.x), bflo(c2.y), bfhi(c2.y), bflo(c2.z), bfhi(c2.z), bflo(c2.w), bfhi(c2.w)};
        float o1[8], o2[8];
#pragma unroll
        for (int k = 0; k < 8; ++k) { const float cs = ROPE[2 * (pos * 16 + f0 + k)], sn = ROPE[2 * (pos * 16 + f0 + k) + 1]; o1[k] = (x1[k] * cs - x2[k] * sn) * qs; o2[k] = (x2[k] * cs + x1[k] * sn) * qs; }
        u32x4 w1, w2; w1.x = pk2(o1[0], o1[1]); w1.y = pk2(o1[2], o1[3]); w1.z = pk2(o1[4], o1[5]); w1.w = pk2(o1[6], o1[7]); w2.x = pk2(o2[0], o2[1]); w2.y = pk2(o2[2], o2[3]); w2.z = pk2(o2[4], o2[5]); w2.w = pk2(o2[6], o2[7]);
        *(u32x4*)p = w1; *(u32x4*)(p + 32) = w2; }
    for (int it = gw; it < NB * 4 * 68; it += NGW) { int t = it; const int sc = t % 68; t /= 68; const int cb = t % 4; const int b = t / 4;
        tr_item(P1, OIN, 2304 + 64 * cb, b, 64 * sc, VT1 + (size_t)(b * 256 + 64 * cb) * SL, 0, 0.f, (LAS unsigned short*)wscr, lane); }
    GSYNC();
    for (int vb = bid; vb < NB * 4 * 128; vb += G) { const int qg = vb % 128; const int kvh = (vb / 128) % 4; const int b = vb / 512;
        attn_unit(b, kvh * 8 + wave, 32 * qg, P1, VT1, A.odd_sink, AO, lane); }
    GSYNC();
    GEMM(0, AO, ws + WS_WOUT1, NLAT, DM, DM, O1B, DM, 0, 0, 1.f, nullptr, 0, nullptr);
    GSYNC();
    for (int row = gw; row < NLAT; row += NGW) { const int mr = row / SEQ; float* xd = A.out + (size_t)row * DM;
        row_pass(xd, O1B + (size_t)row * DM, MODV(1, 2, mr), NG(1, 1), xd, NG(1, 2), MODV(1, 3, mr), MODV(1, 4, mr), XN + (size_t)row * DM, lane); }
    GSYNC();
    GEMM(1, XN, ws + WS_W1_1, NLAT, FF, DM, HB, FF, 0, 0, 1.f, nullptr, 0, nullptr);
    GSYNC();
    GEMM(0, HB, ws + WS_W2_1, NLAT, DM, FF, O2, DM, 0, 0, 1.f, nullptr, 0, nullptr);
    GSYNC();
    for (int row = gw; row < NLAT; row += NGW) { const int mr = row / SEQ; float* xd = A.out + (size_t)row * DM;
        row_pass(xd, O2 + (size_t)row * DM, MODV(1, 5, mr), NG(1, 3), xd, nullptr, nullptr, nullptr, nullptr, lane); }
}

extern "C" void kernel_launch(void* const* d_in, const int* in_sizes, int n_in, void* d_out, int out_size, void* d_ws, size_t ws_size, hipStream_t stream) {
    static int grid = 0;
    if (grid == 0) {
        if (n_in != 24 || ws_size < WS_END) { fprintf(stderr, "kernel_launch: unexpected n_in %d / ws_size %zu (need %zu)\n", n_in, ws_size, (size_t)WS_END); grid = -1; return; }
        int dev = 0, cus = 0, per_cu = 0;
        (void)hipGetDevice(&dev); (void)hipDeviceGetAttribute(&cus, hipDeviceAttributeMultiprocessorCount, dev);
        (void)hipFuncSetAttribute((const void*)fwd_megakernel, hipFuncAttributeMaxDynamicSharedMemorySize, LDS_BYTES);
        if (hipOccupancyMaxActiveBlocksPerMultiprocessor(&per_cu, (const void*)fwd_megakernel, 512, LDS_BYTES) != hipSuccess || per_cu < 1) per_cu = 1;
        (void)hipGetLastError();
        grid = cus * 1;
    }
    if (grid < 0) return;
    Args a{};
    const float** f = (const float**)&a;
    for (int i = 0; i < 24; ++i) f[i] = (const float*)d_in[i];
    a.out = (float*)d_out; a.ws = (unsigned char*)d_ws;
    void* args[] = {&a};
    hipError_t e = hipLaunchCooperativeKernel((const void*)fwd_megakernel, dim3(grid), dim3(512), args, LDS_BYTES, stream);
    if (e != hipSuccess) fprintf(stderr, "cooperative launch failed: %s (grid %d)\n", hipGetErrorString(e), grid);
}
```

```cpp
#include <hip/hip_runtime.h>
#include <hip/hip_cooperative_groups.h>
#include <cstdio>
#include <cstdint>
namespace cg = cooperative_groups;
constexpr int DM = 2048, NB = 4, SEQ = 4096, CTXL = 256, NLAT = NB * SEQ, NCTX = NB * CTXL, NTOK = NLAT + NCTX, SL = SEQ + CTXL;
constexpr int FF = 8192, EIN = 5120, OIN = 2560;
constexpr float EPS = 1e-6f;
constexpr size_t MiB = 1u << 20;
constexpr size_t WS_WIN0 = 0, WS_GLU = 20 * MiB, WS_WOUT0 = 22 * MiB, WS_W1_0 = 30 * MiB, WS_W2_0 = 62 * MiB, WS_WIN1 = 94 * MiB, WS_WOUT1 = 104 * MiB, WS_W1_1 = 112 * MiB, WS_W2_1 = 144 * MiB;
constexpr size_t WS_XN = 176 * MiB;
constexpr size_t WS_MOD = 244 * MiB, WS_ROPE = 245 * MiB, WS_S5E = 246 * MiB, WS_XC = 247 * MiB;
constexpr size_t WS_BAR = 244 * MiB + 768 * 1024;
constexpr size_t WS_BIG = 256 * MiB;
constexpr size_t WS_P = WS_BIG, WS_B2 = WS_BIG + 170 * MiB, WS_KTF = WS_BIG + 272 * MiB, WS_KTB = WS_BIG + 306 * MiB, WS_LOC = WS_BIG + 340 * MiB, WS_A2 = WS_BIG + 272 * MiB, WS_ORET = WS_BIG + 374 * MiB;
constexpr size_t WS_YF = WS_BIG + 272 * MiB, WS_YB = WS_BIG + 306 * MiB, WS_YG = WS_B2;
constexpr size_t WS_O1 = WS_BIG, WS_HB = WS_BIG, WS_O2 = WS_BIG + 272 * MiB;
constexpr size_t WS_O1C = WS_BIG + 68 * MiB, WS_O2C = WS_BIG + 340 * MiB;
constexpr size_t WS_P1 = WS_BIG, WS_VT1 = WS_BIG + 88 * MiB, WS_AO = WS_BIG + 100 * MiB, WS_O1B = WS_BIG + 170 * MiB;
constexpr size_t WS_END = WS_BIG + 408 * MiB;
constexpr int LDS_BYTES = 155648;
__device__ __forceinline__ int rowF(int b, int s) { return s < CTXL ? NLAT + b * CTXL + s : b * SEQ + (s - CTXL); }
__device__ __forceinline__ int rowB(int b, int s) { return s < CTXL ? NLAT + b * CTXL + (CTXL - 1 - s) : b * SEQ + (SEQ - 1 - (s - CTXL)); }
__device__ __forceinline__ float ret_lg2(int h, int dir) {
    const float x = exp2f(-5.f - 2.f * (float)h - (float)dir);
    const float l = -x * (1.f + x * (0.5f + x * (1.f / 3.f + x * (0.25f + x * (0.2f + x * (1.f / 6.f + x * (1.f / 7.f)))))));
    return l * 1.4426950408889634f;
}
namespace pg8 {
#define PG8_LAS __attribute__((address_space(3)))
typedef unsigned short bf16_t;
typedef short bf16x8 __attribute__((ext_vector_type(8)));
typedef float f32x4 __attribute__((ext_vector_type(4)));
typedef unsigned u32x4 __attribute__((ext_vector_type(4)));
constexpr int BM = 256, BK = 64, HALF = 128, HTB = HALF * BK * 2  , STAGE_BYTES = 8 * HTB, NXCD = 8, WGM = 4;

__host__ __device__ __forceinline__ int lds_byte(int r, int c) { const int st = (r >> 4) * 2 + (c >> 5), rr = r & 15, cc = c & 31, ob = rr * 64 + cc * 2; return st * 1024 + (ob ^ (((ob >> 9) & 1) << 5)); }
__host__ __device__ __forceinline__ void stage_rc(int b, int& R, int& C) { const int st = b / 1024, sb = b % 1024, swz = sb ^ (((sb >> 9) & 1) << 5); R = (st >> 1) * 16 + swz / 64; C = (st & 1) * 32 + (swz % 64) / 2; }
__host__ __device__ __forceinline__ int perm32(int rho) { const int n = rho >> 4, i = rho & 15; return 8 * (i >> 2) + 4 * n + (i & 3); }

struct Unit { int pm, pn, z; const char* a; const char* b; };
struct Gemm { int K, lda, ldb; };

struct StaticOrder {
    int nM, nN, nwg, G, c; const char* A; const char* B; size_t tsa, tsb;
    __host__ __device__ void init(const void* A_, const void* B_, int M, int N, int lda, int ldb, int G_, int c_) { nM = M / BM; nN = N / BM; nwg = nM * nN; G = G_; c = c_; A = (const char*)A_; B = (const char*)B_; tsa = (size_t)BM * lda * 2; tsb = (size_t)BM * ldb * 2; }
    __host__ __device__ bool next(int i, Unit& u) const {
        const long L = (long)i * G + c; if (L >= nwg) return false;
        int wgid = (int)L; { const int q = nwg / NXCD, r = nwg % NXCD, xcd = wgid % NXCD, off = wgid / NXCD; wgid = (xcd < r ? xcd * (q + 1) : r * (q + 1) + (xcd - r) * q) + off; }
        const int nig = WGM * nN, gid = wgid / nig, fm = gid * WGM, gsz = (nM - fm) < WGM ? (nM - fm) : WGM;
        u.pm = fm + ((wgid % nig) % gsz); u.pn = (wgid % nig) / gsz; u.z = 0; u.a = A + (size_t)u.pm * tsa; u.b = B + (size_t)u.pn * tsb; return true;
    }
    __device__ __forceinline__ void a_ready(const Unit&) const {}
    __device__ __forceinline__ void done(const Unit&) const {}
};

typedef float f32x2 __attribute__((ext_vector_type(2))); typedef __bf16 bf16x2v __attribute__((ext_vector_type(2)));
__device__ __forceinline__ unsigned cvt_pk_bf16(float lo, float hi) { f32x2 v = {lo, hi}; bf16x2v b = __builtin_convertvector(v, bf16x2v); return __builtin_bit_cast(unsigned, b); }
__device__ __forceinline__ float bf_lo(unsigned w) { return __uint_as_float(w << 16); }
__device__ __forceinline__ float bf_hi(unsigned w) { return __uint_as_float(w & 0xffff0000u); }
template <int MODE> struct EpiX {
    static constexpr bool PERM = true, AFTER_DRAIN = false;
    bf16_t* O; int ldc; int sc_lo, sc_hi; float sc; const bf16_t* yg; int ldy; const float* bias; size_t zs;
    __device__ __forceinline__ void operator()(const f32x4 (&acc)[2][2][4][2], const Unit& u, int wr, int wc, int fr, int fq) const {
        const int row0 = u.pm * BM + wr * 64 + fr; const int colt = u.pn * BM; const int col0 = colt + wc * 32 + 8 * fq;
        float s = 1.f; if (MODE == 0) { if (colt >= sc_lo && colt < sc_hi) s = sc; }
        bf16_t* Ob = O + (size_t)u.z * zs;
        float lgf = 0.f, lgb = 0.f;
        int zz = 0;
        if (MODE == 3) { const int h = (u.z / 17) & 3; lgf = ::ret_lg2(h, 0); lgb = ::ret_lg2(h, 1); asm volatile("" : "+v"(zz)); }
        if (MODE == 4) { const int b = u.z / 68, h = (u.z / 17) & 3, c = u.z % 17; Ob = O + (size_t)::rowF(b, 256 * c) * 1024 + h * 256; }
#pragma unroll
        for (int ai = 0; ai < 2; ++ai)
#pragma unroll
            for (int m = 0; m < 4; ++m) { const int row = row0 + ai * HALF + m * 16;
#pragma unroll
                for (int bj = 0; bj < 2; ++bj) { const int col = col0 + bj * HALF; f32x4 v0 = acc[ai][bj][m][0], v1 = acc[ai][bj][m][1];
                    if (MODE == 0) { v0 = v0 * s; v1 = v1 * s; }
                    if (MODE == 5) { if (colt < 2304 && u.pm < ::NLAT / 256) {
                        const float qs = colt < 2048 ? 0.125f : 1.f; const int tok = row & (::SEQ - 1); const int j0 = (col & 63) >> 1;
                        const int pos = j0 < 16 ? (tok >> 6) : (tok & 63); const float* rp = bias + 2 * (pos * 16 + (j0 & 15));
                        const f32x4 t0 = *(const f32x4*)rp, t1 = *(const f32x4*)(rp + 4);
                        const f32x4 a = v0, b = v1;
                        v0[0] = (a[0] * t0[0] - a[1] * t0[1]) * qs; v0[1] = (a[1] * t0[0] + a[0] * t0[1]) * qs; v0[2] = (a[2] * t0[2] - a[3] * t0[3]) * qs; v0[3] = (a[3] * t0[2] + a[2] * t0[3]) * qs;
                        v1[0] = (b[0] * t1[0] - b[1] * t1[1]) * qs; v1[1] = (b[1] * t1[0] + b[0] * t1[1]) * qs; v1[2] = (b[2] * t1[2] - b[3] * t1[3]) * qs; v1[3] = (b[3] * t1[2] + b[2] * t1[3]) * qs; }
                        else { v0 = v0 * s; v1 = v1 * s; } }
                    if (MODE == 3) {
#pragma unroll
                        for (int e2 = 0; e2 < 4; ++e2) { const float d0 = (float)(row - col - e2 + zz), d1 = d0 - 4.f;
                            v0[e2] *= (d0 >= 0.f ? exp2f(d0 * lgf) : 0.f) + (d0 <= 0.f ? exp2f(-d0 * lgb) : 0.f);
                            v1[e2] *= (d1 >= 0.f ? exp2f(d1 * lgf) : 0.f) + (d1 <= 0.f ? exp2f(-d1 * lgb) : 0.f); } }
                    if (MODE == 1) {
#pragma unroll
                        for (int e = 0; e < 4; ++e) { float a = fmaxf(v0[e], 0.f), b = fmaxf(v1[e], 0.f); v0[e] = a * a; v1[e] = b * b; } }
                    if (MODE == 2) { const f32x4 b0 = *(const f32x4*)(bias + col), b1 = *(const f32x4*)(bias + col + 4);
                        const u32x4 y = *(const u32x4*)(yg + (size_t)row * ldy + col);
                        float yf[8] = {bf_lo(y.x), bf_hi(y.x), bf_lo(y.y), bf_hi(y.y), bf_lo(y.z), bf_hi(y.z), bf_lo(y.w), bf_hi(y.w)};
#pragma unroll
                        for (int e = 0; e < 4; ++e) { v0[e] = yf[e] / (1.f + __expf(-(v0[e] + b0[e]))); v1[e] = yf[4 + e] / (1.f + __expf(-(v1[e] + b1[e]))); } }
                    u32x4 w; w.x = cvt_pk_bf16(v0[0], v0[1]); w.y = cvt_pk_bf16(v0[2], v0[3]); w.z = cvt_pk_bf16(v1[0], v1[1]); w.w = cvt_pk_bf16(v1[2], v1[3]);
                    *(u32x4*)(Ob + (size_t)row * ldc + col) = w; } }
    }
};

template <int KIND> struct RetOrder {
    int G, c; const char* P; const char* B2; const char* A2; const char* KTF; const char* KTB;
    __device__ bool next(int i, Unit& u) const {
        const int L = i * G + c; const int nun = KIND == 1 ? 512 : 272; if (L >= nun) return false;
        u.pm = 0; u.pn = 0; u.z = L;
        if (KIND == 1) { const int pc = L & 15, dir = (L >> 4) & 1, bh = L >> 5; const int cc = dir ? (pc == 0 ? 0 : 17 - pc) : pc;
            u.a = B2 + (size_t)((bh * 17 + cc) * 256) * 768 * 2; u.b = (dir ? KTB : KTF) + ((size_t)(bh * 256) * ::SL + 256 * cc) * 2; }
        else if (KIND == 2) { const int b = L / 68, h = (L / 17) & 3, cc = L % 17; const size_t r0 = (size_t)::rowF(b, 256 * cc);
            u.a = P + (r0 * ::EIN + 1024 + h * 256) * 2; u.b = P + (r0 * ::EIN + 2048 + h * 256) * 2; }
        else { u.a = A2 + (size_t)L * 256 * 768 * 2; u.b = B2 + (size_t)L * 256 * 768 * 2; }
        return true;
    }
    __device__ __forceinline__ void a_ready(const Unit&) const {}
    __device__ __forceinline__ void done(const Unit&) const {}
};

struct CtxOrder {
    int G, c; const char* A; const char* B; int lda, ldb, nN, ksplit, Ksub;
    __device__ bool next(int i, Unit& u) const {
        const int L = i * G + c; if (L >= 4 * nN * ksplit) return false;
        const int ks = L % ksplit, t = L / ksplit; u.pn = t % nN; u.pm = t / nN; u.z = ks;
        u.a = A + ((size_t)u.pm * 256 * lda + (size_t)ks * Ksub) * 2; u.b = B + ((size_t)u.pn * 256 * ldb + (size_t)ks * Ksub) * 2; return true;
    }
    __device__ __forceinline__ void a_ready(const Unit&) const {}
    __device__ __forceinline__ void done(const Unit&) const {}
};
template <class Epi, class Sched, bool ALIGN_EPI = false, bool SP2 = false>
__device__ __forceinline__ void gemm_phase(PG8_LAS unsigned char* lds, const Gemm g, const Sched& S, const Epi& E, const int wid_s  ) {
    unsigned om_ = ~0u; asm volatile("" : "+s"(om_));
    const int tid0_ = wid_s * 64 + (int)__builtin_amdgcn_mbcnt_hi(om_, __builtin_amdgcn_mbcnt_lo(om_, 0u));
    const int tid = tid0_, wid = __builtin_amdgcn_readfirstlane(tid >> 6), lane = tid & 63, wr = wid >> 2, wc = wid & 3, fr = lane & 15, fq = lane >> 4;
    const int K = g.K, nt = K / BK;
    unsigned voffA[2], voffB[2];
#pragma unroll
    for (int i = 0; i < 2; ++i) { int R, C; stage_rc(tid * 16 + i * 8192, R, C); const int Rb = Epi::PERM ? ((R & ~31) + perm32(R & 31)) : R;
        voffA[i] = (unsigned)(R * g.lda + C) * 2u; voffB[i] = (unsigned)(Rb * g.ldb + C) * 2u; }
    const size_t kstep = (size_t)(BK * 2);
    const size_t hstepA = (size_t)HALF * g.lda * 2, hstepB = (size_t)HALF * g.ldb * 2;
    const unsigned ldsw = (unsigned)wid * 1024u;
    const int aoff = lds_byte(wr * 64 + fr, fq * 8), boff = lds_byte(wc * 32 + fr, fq * 8);
#define PG8_SA(b, h) (((b) * 2 + (h)) * HTB)
#define PG8_SB(b, h) ((4 + (b) * 2 + (h)) * HTB)
#define PG8_STAGE(bufoff, gbase, voff) do { _Pragma("unroll") for (int _i = 0; _i < 2; ++_i) \
        __builtin_amdgcn_global_load_lds((const unsigned*)((const char*)(gbase) + (voff)[_i]), (PG8_LAS unsigned*)(lds + (bufoff) + ldsw + _i * 8192), 16, 0, 0); } while (0)
#define PG8_LDA(dst, b, h) do { _Pragma("unroll") for (int m = 0; m < 4; ++m) _Pragma("unroll") for (int k = 0; k < 2; ++k) dst[m][k] = *(const PG8_LAS bf16x8*)(lds + PG8_SA(b, h) + aoff + m * 2048 + k * 1024); } while (0)
#define PG8_LDB(dst, b, h) do { _Pragma("unroll") for (int n = 0; n < 2; ++n) _Pragma("unroll") for (int k = 0; k < 2; ++k) dst[n][k] = *(const PG8_LAS bf16x8*)(lds + PG8_SB(b, h) + boff + n * 2048 + k * 1024); } while (0)
#define PG8_MMA(ai, bj, At, Bt) do { __builtin_amdgcn_s_setprio(1); _Pragma("unroll") for (int m = 0; m < 4; ++m) _Pragma("unroll") for (int n = 0; n < 2; ++n) _Pragma("unroll") for (int k = 0; k < 2; ++k) \
        acc[ai][bj][m][n] = __builtin_amdgcn_mfma_f32_16x16x32_bf16(Bt[n][k], At[m][k], acc[ai][bj][m][n], 0, 0, 0); __builtin_amdgcn_s_setprio(0); } while (0)
#define PG8_WAIT_V(n) asm volatile("s_waitcnt vmcnt(" #n ")" ::: "memory")
#define PG8_WAIT_L(n) asm volatile("s_waitcnt lgkmcnt(" #n ")" ::: "memory")
#define PG8_BAR __builtin_amdgcn_s_barrier()
#define PG8_SCHED __builtin_amdgcn_sched_barrier(0)
    Unit cur, nxt; int ui = 0;
    if (!S.next(0, cur)) return;
    f32x4 acc[2][2][4][2];
#pragma unroll
    for (int a = 0; a < 2; ++a)
#pragma unroll
        for (int b = 0; b < 2; ++b)
#pragma unroll
            for (int m = 0; m < 4; ++m)
#pragma unroll
                for (int n = 0; n < 2; ++n) acc[a][b][m][n] = (f32x4){0.f, 0.f, 0.f, 0.f};
    bf16x8 At[4][2], B0[2][2], B1[2][2];
    const char* cA = cur.a; const char* cB = cur.b;
    S.a_ready(cur);
    if constexpr (SP2) {
        PG8_STAGE(PG8_SB(0, 0), cB, voffB); PG8_STAGE(PG8_SB(0, 1), cB + hstepB, voffB); PG8_STAGE(PG8_SA(0, 0), cA, voffA); PG8_STAGE(PG8_SA(0, 1), cA + hstepA, voffA);
        if (wr == 1) PG8_BAR;
        PG8_WAIT_V(2); PG8_BAR;
        PG8_STAGE(PG8_SB(1, 0), cB + kstep, voffB); PG8_STAGE(PG8_SA(1, 0), cA + kstep, voffA); PG8_STAGE(PG8_SB(1, 1), cB + hstepB + kstep, voffB);
        PG8_WAIT_V(6); PG8_BAR;
    } else {
        PG8_STAGE(PG8_SB(0, 0), cB, voffB); PG8_STAGE(PG8_SA(0, 0), cA, voffA); PG8_STAGE(PG8_SB(0, 1), cB + hstepB, voffB); PG8_STAGE(PG8_SA(0, 1), cA + hstepA, voffA);
        if (wr == 1) PG8_BAR;
        PG8_WAIT_V(4); PG8_BAR;
        PG8_STAGE(PG8_SB(1, 0), cB + kstep, voffB); PG8_STAGE(PG8_SA(1, 0), cA + kstep, voffA); PG8_STAGE(PG8_SB(1, 1), cB + hstepB + kstep, voffB);
        PG8_WAIT_V(6); PG8_BAR;
    }
    for (;;) {
        const bool has_next = S.next(ui + 1, nxt);
        const char* nA = has_next ? nxt.a : cA; const char* nB = has_next ? nxt.b : cB;
        for (int t = 0; t < nt; t += 2) {
            const bool last = (t == nt - 2);
            const char* a1 = cA + (size_t)(t + 1) * kstep;
            const char* a2 = last ? nA : cA + (size_t)(t + 2) * kstep; const char* b2 = last ? nB : cB + (size_t)(t + 2) * kstep;
            const char* a3 = a2 + kstep; const char* b3 = b2 + kstep;
            if (last && has_next) S.a_ready(nxt);
            if constexpr (SP2) {
            PG8_LDB(B0, 0, 0); PG8_LDB(B1, 0, 1); PG8_SCHED; PG8_LDA(At, 0, 0); PG8_STAGE(PG8_SA(1, 1), a1 + hstepA, voffA);
            PG8_WAIT_V(8); PG8_WAIT_L(0); PG8_BAR; PG8_MMA(0, 0, At, B0); PG8_MMA(0, 1, At, B1); PG8_BAR; PG8_SCHED;
            PG8_LDA(At, 0, 1); PG8_STAGE(PG8_SB(0, 0), b2, voffB); PG8_STAGE(PG8_SB(0, 1), b2 + hstepB, voffB); PG8_STAGE(PG8_SA(0, 0), a2, voffA);
            PG8_WAIT_V(8); PG8_WAIT_L(0); PG8_BAR; PG8_MMA(1, 0, At, B0); PG8_MMA(1, 1, At, B1); PG8_BAR; PG8_SCHED;
            PG8_LDB(B0, 1, 0); PG8_LDB(B1, 1, 1); PG8_SCHED; PG8_LDA(At, 1, 0); PG8_STAGE(PG8_SA(0, 1), a2 + hstepA, voffA);
            PG8_WAIT_V(8); PG8_WAIT_L(0); PG8_BAR; PG8_MMA(0, 0, At, B0); PG8_MMA(0, 1, At, B1); PG8_BAR; PG8_SCHED;
            PG8_LDA(At, 1, 1); PG8_STAGE(PG8_SB(1, 0), b3, voffB); PG8_STAGE(PG8_SB(1, 1), b3 + hstepB, voffB); PG8_STAGE(PG8_SA(1, 0), a3, voffA);
            PG8_WAIT_V(8); PG8_WAIT_L(0); PG8_BAR; PG8_MMA(1, 0, At, B0); PG8_MMA(1, 1, At, B1); PG8_BAR; PG8_SCHED;
            } else {
            PG8_LDB(B0, 0, 0); PG8_SCHED; PG8_LDA(At, 0, 0); PG8_STAGE(PG8_SA(1, 1), a1 + hstepA, voffA);
            PG8_WAIT_L(8); PG8_BAR; PG8_WAIT_L(0); PG8_MMA(0, 0, At, B0); PG8_BAR; PG8_SCHED;
            PG8_LDB(B1, 0, 1); PG8_STAGE(PG8_SB(0, 0), b2, voffB);
            PG8_BAR; PG8_WAIT_L(0); PG8_MMA(0, 1, At, B1); PG8_BAR;
            PG8_LDA(At, 0, 1); PG8_STAGE(PG8_SA(0, 0), a2, voffA);
            PG8_BAR; PG8_WAIT_L(0); PG8_MMA(1, 0, At, B0); PG8_BAR; PG8_SCHED;
            PG8_STAGE(PG8_SB(0, 1), b2 + hstepB, voffB);
            PG8_WAIT_V(6); PG8_BAR; PG8_MMA(1, 1, At, B1); PG8_BAR;
            PG8_LDB(B0, 1, 0); PG8_SCHED; PG8_LDA(At, 1, 0); PG8_STAGE(PG8_SA(0, 1), a2 + hstepA, voffA);
            PG8_WAIT_L(8); PG8_BAR; PG8_WAIT_L(0); PG8_MMA(0, 0, At, B0); PG8_BAR; PG8_SCHED;
            PG8_LDB(B1, 1, 1); PG8_STAGE(PG8_SB(1, 0), b3, voffB);
            PG8_BAR; PG8_WAIT_L(0); PG8_MMA(0, 1, At, B1); PG8_BAR;
            PG8_LDA(At, 1, 1); PG8_STAGE(PG8_SA(1, 0), a3, voffA);
            PG8_BAR; PG8_WAIT_L(0); PG8_MMA(1, 0, At, B0); PG8_BAR; PG8_SCHED;
            PG8_STAGE(PG8_SB(1, 1), b3 + hstepB, voffB);
            PG8_WAIT_V(6); PG8_BAR; PG8_MMA(1, 1, At, B1); PG8_BAR;
            }
        }
        if constexpr (ALIGN_EPI) { if (wr == 0) PG8_BAR; }
        if constexpr (!Epi::AFTER_DRAIN) { E(acc, cur, wr, wc, fr, fq); S.done(cur); }
        if (!has_next) break;
#pragma unroll
        for (int a = 0; a < 2; ++a)
#pragma unroll
            for (int b = 0; b < 2; ++b)
#pragma unroll
                for (int m = 0; m < 4; ++m)
#pragma unroll
                    for (int n = 0; n < 2; ++n) acc[a][b][m][n] = (f32x4){0.f, 0.f, 0.f, 0.f};
        cur = nxt; cA = nA; cB = nB; ++ui;
        if constexpr (ALIGN_EPI) { if (wr == 1) PG8_BAR; }
    }
    PG8_WAIT_V(0);
    if constexpr (!ALIGN_EPI) { if (wr == 0) PG8_BAR; }
    PG8_BAR;
    if constexpr (Epi::AFTER_DRAIN) { E.fused(acc, cur, wr, wc, fr, fq, lds, wid, lane); S.done(cur); }
#undef PG8_SA
#undef PG8_SB
#undef PG8_STAGE
#undef PG8_LDA
#undef PG8_LDB
#undef PG8_MMA
#undef PG8_WAIT_V
#undef PG8_WAIT_L
#undef PG8_BAR
#undef PG8_SCHED
}
}
#define LAS __attribute__((address_space(3)))
typedef unsigned short bf16_t;
typedef short bf16x8 __attribute__((ext_vector_type(8)));
typedef float f32x4 __attribute__((ext_vector_type(4)));
typedef unsigned u32x4 __attribute__((ext_vector_type(4)));
typedef unsigned u32x2 __attribute__((ext_vector_type(2)));

__device__ __forceinline__ float bf2f(unsigned short h) { return __uint_as_float((unsigned)h << 16); }
__device__ __forceinline__ float bflo(unsigned w) { return __uint_as_float(w << 16); }
__device__ __forceinline__ float bfhi(unsigned w) { return __uint_as_float(w & 0xffff0000u); }
typedef float f32x2_t __attribute__((ext_vector_type(2))); typedef __bf16 bf16x2_t __attribute__((ext_vector_type(2)));
__device__ __forceinline__ unsigned pk2(float lo, float hi) { f32x2_t v = {lo, hi}; bf16x2_t b = __builtin_convertvector(v, bf16x2_t); return __builtin_bit_cast(unsigned, b); }
__device__ __forceinline__ unsigned short f2bf(float f) { return (unsigned short)(pk2(f, 0.f) & 0xffffu); }
__device__ __forceinline__ f32x4 mfma16(bf16x8 a, bf16x8 b, f32x4 c) { return __builtin_amdgcn_mfma_f32_16x16x32_bf16(a, b, c, 0, 0, 0); }
__device__ __forceinline__ bf16x8 ldfrag(const bf16_t* base, int ld, int r, int q) { return *(const bf16x8*)(base + (size_t)r * ld + 8 * q); }
__device__ __forceinline__ float wave_sum(float v) {
#pragma unroll
    for (int o = 1; o < 64; o <<= 1) v += __shfl_xor(v, o);
    return v;
}
#define LDS_WAIT() asm volatile("s_waitcnt lgkmcnt(0)" ::: "memory")
__device__ __forceinline__ bf16x8 scale_frag(bf16x8 v, float s) {
    u32x4 w = __builtin_bit_cast(u32x4, v); u32x4 o;
    o.x = pk2(bflo(w.x) * s, bfhi(w.x) * s); o.y = pk2(bflo(w.y) * s, bfhi(w.y) * s); o.z = pk2(bflo(w.z) * s, bfhi(w.z) * s); o.w = pk2(bflo(w.w) * s, bfhi(w.w) * s);
    return __builtin_bit_cast(bf16x8, o);
}

struct Args {
    const float *x, *c, *ctx, *c_ctx, *mod_w, *mod_b, *norm_g, *mlp_w1, *mlp_w2, *even_w_in, *even_w_out;
    const float *lam_re, *lam_im, *log_dt, *b_re, *b_im, *c_re, *c_im, *s5_d, *glu_w, *glu_b, *odd_w_in, *odd_w_out, *odd_sink;
    float* out; unsigned char* ws;
};

__device__ __forceinline__ void phase_mod(const Args& A, float* MOD, LAS float* ldsf, int tid, int wave, int lane, int bid, int G) {
    for (int i = tid; i < 5 * DM; i += 512) { const int r = i / DM, k = i % DM; const float v = r < 4 ? A.c[r * DM + k] : A.c_ctx[k]; ldsf[i] = v / (1.f + expf(-v)); }
    __syncthreads();
    LAS float* red = ldsf + 5 * DM;
    for (int it = bid; it < 512; it += G) {
        const int L = it / 256, cc = it % 256, col = cc * 48 + (lane < 48 ? lane : 47);
        const float* w = A.mod_w + (size_t)L * DM * 12288 + col;
        float a0 = 0.f, a1 = 0.f, a2 = 0.f, a3 = 0.f, a4 = 0.f;
        const int k0 = wave * 256;
#pragma unroll 32
        for (int k = k0; k < k0 + 256; ++k) { const float wv = w[(size_t)k * 12288]; a0 += ldsf[k] * wv; a1 += ldsf[DM + k] * wv; a2 += ldsf[2 * DM + k] * wv; a3 += ldsf[3 * DM + k] * wv; a4 += ldsf[4 * DM + k] * wv; }
        red[(wave * 5 + 0) * 64 + lane] = a0; red[(wave * 5 + 1) * 64 + lane] = a1; red[(wave * 5 + 2) * 64 + lane] = a2; red[(wave * 5 + 3) * 64 + lane] = a3; red[(wave * 5 + 4) * 64 + lane] = a4;
        __syncthreads();
        if (wave == 0 && lane < 48) {
            const float bias = A.mod_b[L * 12288 + col]; const int k6 = col / DM, cw = col % DM;
#pragma unroll
            for (int r = 0; r < 5; ++r) { float s = 0.f;
#pragma unroll
                for (int w8 = 0; w8 < 8; ++w8) s += red[(w8 * 5 + r) * 64 + lane];
                float v = s + bias;
                if (k6 == 1) v = (1.f + v) * A.norm_g[(L * 4 + 0) * DM + cw]; else if (k6 == 4) v = (1.f + v) * A.norm_g[(L * 4 + 2) * DM + cw];
                else if (k6 == 2) v = v * A.norm_g[(L * 4 + 1) * DM + cw]; else if (k6 == 5) v = v * A.norm_g[(L * 4 + 3) * DM + cw];
                MOD[((L * 6 + k6) * 5 + r) * DM + cw] = v; }
        }
        __syncthreads();
    }
}
__device__ __forceinline__ void p0_transpose_item(const float* W, int K, int N, bf16_t* WT, LAS float* scr, int item, int lane, bool perm = false) {
    const int nblk = N / 32, kb = item / nblk, nb = item % nblk, k0 = 64 * kb, n0 = 32 * nb;
    float wv[32];
#pragma unroll
    for (int i = 0; i < 32; ++i) { const int kk = 2 * i + (lane >> 5); wv[i] = W[(size_t)(k0 + kk) * N + n0 + (lane & 31)]; }
#pragma unroll
    for (int i = 0; i < 32; ++i) { const int kk = 2 * i + (lane >> 5); scr[kk * 33 + (lane & 31)] = wv[i]; }
    LDS_WAIT();
    const int c = lane & 7;
#pragma unroll
    for (int j = 0; j < 4; ++j) { const int n = (lane >> 3) + 8 * j; const LAS float* s = scr + (8 * c) * 33 + n;
        u32x4 o; o.x = pk2(s[0 * 33], s[1 * 33]); o.y = pk2(s[2 * 33], s[3 * 33]); o.z = pk2(s[4 * 33], s[5 * 33]); o.w = pk2(s[6 * 33], s[7 * 33]);
        int rn = n0 + n; if (perm && rn < 2304) rn = (rn & ~63) | ((rn & 31) << 1) | ((rn >> 5) & 1);
        *(u32x4*)(WT + (size_t)rn * K + k0 + 8 * c) = o; }
    LDS_WAIT();
}
__device__ __forceinline__ void phase_wconv(const Args& A, unsigned char* ws, LAS float* scr, int gw, int NGW, int lane) {
    constexpr int I0 = (DM / 64) * (EIN / 32), I1 = (1024 / 64) * (1024 / 32), I2 = (DM / 64) * (DM / 32), I3 = (DM / 64) * (FF / 32), I4 = (FF / 64) * (DM / 32), I5 = (DM / 64) * (OIN / 32);
    constexpr int NIT = I0 + I1 + I2 + 2 * I3 + 2 * I4 + I5 + I2;
    for (int it = gw; it < NIT; it += NGW) {
        int r = it;
        if (r < I0) { p0_transpose_item(A.even_w_in, DM, EIN, (bf16_t*)(ws + WS_WIN0), scr, r, lane); continue; } r -= I0;
        if (r < I1) { p0_transpose_item(A.glu_w, 1024, 1024, (bf16_t*)(ws + WS_GLU), scr, r, lane); continue; } r -= I1;
        if (r < I2) { p0_transpose_item(A.even_w_out, DM, DM, (bf16_t*)(ws + WS_WOUT0), scr, r, lane); continue; } r -= I2;
        if (r < I3) { p0_transpose_item(A.mlp_w1, DM, FF, (bf16_t*)(ws + WS_W1_0), scr, r, lane); continue; } r -= I3;
        if (r < I4) { p0_transpose_item(A.mlp_w2, FF, DM, (bf16_t*)(ws + WS_W2_0), scr, r, lane); continue; } r -= I4;
        if (r < I5) { p0_transpose_item(A.odd_w_in, DM, OIN, (bf16_t*)(ws + WS_WIN1), scr, r, lane, true); continue; } r -= I5;
        if (r < I2) { p0_transpose_item(A.odd_w_out, DM, DM, (bf16_t*)(ws + WS_WOUT1), scr, r, lane); continue; } r -= I2;
        if (r < I3) { p0_transpose_item(A.mlp_w1 + (size_t)DM * FF, DM, FF, (bf16_t*)(ws + WS_W1_1), scr, r, lane); continue; } r -= I3;
        p0_transpose_item(A.mlp_w2 + (size_t)DM * FF, FF, DM, (bf16_t*)(ws + WS_W2_1), scr, r, lane);
    }
}
__device__ __forceinline__ void row_pass(const float* xs, const bf16_t* orow, const float* gate, const float* gpost, float* xd,
                                         const float* gpre, const float* shift, const float* scale, bf16_t* hd, int lane, int nparts = 1, size_t pstride = 0) {
    f32x4 v[8];
#pragma unroll
    for (int j = 0; j < 8; ++j) v[j] = *(const f32x4*)(xs + 4 * lane + 256 * j);
    if (orow) {
        f32x4 o[8]; float ss = 0.f;
#pragma unroll
        for (int j = 0; j < 8; ++j) { const u32x2 w = *(const u32x2*)(orow + 4 * lane + 256 * j); o[j] = (f32x4){bflo(w.x), bfhi(w.x), bflo(w.y), bfhi(w.y)}; }
        for (int p = 1; p < nparts; ++p) {
#pragma unroll
            for (int j = 0; j < 8; ++j) { const u32x2 w = *(const u32x2*)(orow + (size_t)p * pstride + 4 * lane + 256 * j); o[j] = o[j] + (f32x4){bflo(w.x), bfhi(w.x), bflo(w.y), bfhi(w.y)}; } }
#pragma unroll
        for (int j = 0; j < 8; ++j) ss += (o[j].x * o[j].x + o[j].y * o[j].y) + (o[j].z * o[j].z + o[j].w * o[j].w);
        ss = wave_sum(ss); const float rinv = 1.0f / sqrtf(ss * (1.f / DM) + EPS);
#pragma unroll
        for (int j = 0; j < 8; ++j) { const f32x4 g = *(const f32x4*)(gate + 4 * lane + 256 * j); v[j] = v[j] + g * (o[j] * rinv); }
        if (xd) {
#pragma unroll
            for (int j = 0; j < 8; ++j) *(f32x4*)(xd + 4 * lane + 256 * j) = v[j]; }
    }
    if (hd) {
        float ss = 0.f;
#pragma unroll
        for (int j = 0; j < 8; ++j) ss += (v[j].x * v[j].x + v[j].y * v[j].y) + (v[j].z * v[j].z + v[j].w * v[j].w);
        ss = wave_sum(ss); const float rinv = 1.0f / sqrtf(ss * (1.f / DM) + EPS);
#pragma unroll
        for (int j = 0; j < 8; ++j) { const int col = 4 * lane + 256 * j; const f32x4 sh = *(const f32x4*)(shift + col), sc = *(const f32x4*)(scale + col);
            const f32x4 h = (v[j] * rinv) * sc + sh; u32x2 w; w.x = pk2(h.x, h.y); w.y = pk2(h.z, h.w); *(u32x2*)(hd + col) = w; }
    }
}
#define XB_TMO      128
#define XB_XCNT(j)  (256  + 64 * (j))
#define XB_XSUB(j)  (1280 + 64 * (j))
#define XB_XGEN(j)  (2304 + 64 * (j))
#define XB_TOP      3328
#define XB_TOPGEN   3392
#define XCD_BAR_WORDS 3456
#define XB_SPIN_CAP (1u << 18)

__device__ __forceinline__ unsigned xb_ld(unsigned* p)              { return __hip_atomic_load(p, __ATOMIC_RELAXED, __HIP_MEMORY_SCOPE_AGENT); }
__device__ __forceinline__ unsigned xb_add(unsigned* p, unsigned v) { return __hip_atomic_fetch_add(p, v, __ATOMIC_RELAXED, __HIP_MEMORY_SCOPE_AGENT); }
__device__ __forceinline__ unsigned xb_xcc_id() { return (unsigned)__builtin_amdgcn_s_getreg((3 << 11) | 20) & 0xFu; }
#define XB_SPIN(cond, bar) do { unsigned _sp = 0; while (cond) { __builtin_amdgcn_s_sleep(1); \
    if ((++_sp & 255u) == 0u) { if (xb_ld(&(bar)[XB_TMO])) break; if (_sp > XB_SPIN_CAP) { atomicAdd(&(bar)[XB_TMO], 1u); break; } } } } while (0)

struct XcdBarrier {
    unsigned* bar; unsigned x;
    volatile LAS unsigned* st;
};

__device__ __forceinline__ XcdBarrier xcd_barrier_post(unsigned* bar, volatile LAS unsigned* st) {
    XcdBarrier b; b.bar = bar; b.x = xb_xcc_id(); b.st = st;
    if (threadIdx.x == 0) (void)xb_add(&bar[XB_XCNT(b.x)], 1u);
    return b;
}
__device__ __forceinline__ void xcd_barrier_complete(unsigned* bar, unsigned x, unsigned& nloc, unsigned& nx) {
    const unsigned G = gridDim.x * gridDim.y * gridDim.z;
    unsigned sum, cnt, mine, sp = 0u;
    for (;;) {
        sum = 0u; cnt = 0u; mine = 0u;
#pragma unroll
        for (unsigned j = 0; j < 16; ++j) { const unsigned c = xb_ld(&bar[XB_XCNT(j)]); sum += c; cnt += (c > 0u) ? 1u : 0u; mine = (j == x) ? c : mine; }
        if (sum == G) break;
        __builtin_amdgcn_s_sleep(1);
        if ((++sp & 255u) == 0u) { if (xb_ld(&bar[XB_TMO])) break; if (sp > XB_SPIN_CAP) { atomicAdd(&bar[XB_TMO], 1u); break; } }
    }
    nloc = mine > 0u ? mine : 1u; nx = cnt > 0u ? cnt : 1u;
}

__device__ __forceinline__ void xcd_barrier(const XcdBarrier& b) {
    asm volatile("s_waitcnt vmcnt(0)" ::: "memory");
    __syncthreads();
    if (threadIdx.x == 0) {
        unsigned* bar = b.bar;
        __builtin_amdgcn_s_waitcnt(0);
        unsigned nloc = b.st[0], nx = b.st[1];
        if (nloc == 0u) { xcd_barrier_complete(bar, b.x, nloc, nx); b.st[0] = nloc; b.st[1] = nx; }
        const unsigned old = xb_add(&bar[XB_XSUB(b.x)], 1u);
        const unsigned gen = old / nloc;
        if (old + 1u == (gen + 1u) * nloc) {
            __builtin_amdgcn_fence(__ATOMIC_RELEASE, "agent");
            asm volatile("s_waitcnt vmcnt(0)" ::: "memory");
            const unsigned og = xb_add(&bar[XB_TOP], 1u);
            const unsigned tg = og / nx;
            if (og + 1u == (tg + 1u) * nx) xb_add(&bar[XB_TOPGEN], 1u);
            else XB_SPIN(xb_ld(&bar[XB_TOPGEN]) == tg, bar);
            __builtin_amdgcn_fence(__ATOMIC_ACQUIRE, "agent");
            xb_add(&bar[XB_XGEN(b.x)], 1u);
            asm volatile("s_waitcnt vmcnt(0)" ::: "memory");
        } else {
            XB_SPIN(xb_ld(&bar[XB_XGEN(b.x)]) == gen, bar);
            __builtin_amdgcn_fence(__ATOMIC_ACQUIRE, "agent");
            asm volatile("s_waitcnt vmcnt(0)" ::: "memory");
        }
    }
    __syncthreads();
}
__device__ __forceinline__ void tr_item(const bf16_t* src, int ld, int col0, int b, int s0, bf16_t* outbase, int opitch, int mode, float lg, LAS unsigned short* scr, int lane) {
#pragma unroll
    for (int it = 0; it < 8; ++it) { const int sr = it * 8 + (lane >> 3); const int row = rowF(b, s0 + sr);
        const u32x4 v = *(const u32x4*)(src + (size_t)row * ld + col0 + 8 * (lane & 7));
        LAS unsigned* p = (LAS unsigned*)(scr + sr * 66 + 8 * (lane & 7)); p[0] = v.x; p[1] = v.y; p[2] = v.z; p[3] = v.w; }
    LDS_WAIT();
#pragma unroll
    for (int it = 0; it < 8; ++it) { const int j = it * 8 + (lane >> 3), sc0 = 8 * (lane & 7); float f[8];
#pragma unroll
        for (int k = 0; k < 8; ++k) f[k] = bf2f(scr[(sc0 + k) * 66 + j]);
        if (mode) {
#pragma unroll
            for (int k = 0; k < 8; ++k) { const int i = (s0 + sc0 + k) & 255; const float e = mode == 1 ? (float)(255 - i) : (float)i; f[k] *= exp2f(e * lg); } }
        u32x4 o; o.x = pk2(f[0], f[1]); o.y = pk2(f[2], f[3]); o.z = pk2(f[4], f[5]); o.w = pk2(f[6], f[7]);
        *(u32x4*)(outbase + (size_t)j * opitch + sc0) = o; }
    LDS_WAIT();
}
constexpr int S5_NSEG = 4, S5_LSEG = SL / S5_NSEG;
template <bool EMIT>
__device__ __forceinline__ void s5_scan(const Args& A, int b, int g, int dir, int seg, const bf16_t* P, float* E, bf16_t* Y, LAS unsigned char* scr, int lane) {
    const int n = lane, r = lane & 15, q = lane >> 4;
    const int pg = dir * 64 + g;
    const float lr = fminf(A.lam_re[pg * 64 + n], -1e-4f), li = A.lam_im[pg * 64 + n], dt = expf(A.log_dt[pg]);
    const float zr = lr * dt, zi = li * dt, mag = expf(zr);
    float sn, cs; sincosf(zi, &sn, &cs);
    const float ar = mag * cs, ai = mag * sn, den = lr * lr + li * li, nr = ar - 1.f;
    const float fre = (nr * lr + ai * li) / den, fim = (ai * lr - nr * li) / den;
    LAS float* BU = (LAS float*)scr; LAS unsigned short* Sb = (LAS unsigned short*)(scr + 8448); LAS unsigned short* Bc = (LAS unsigned short*)scr;
    {
        const float* br = A.b_re + (size_t)(pg * 64 + n) * 16; const float* bi = A.b_im + (size_t)(pg * 64 + n) * 16;
#pragma unroll
        for (int p = 0; p < 16; ++p) { const float x = br[p], y = bi[p]; Bc[n * 16 + p] = f2bf(fre * x - fim * y); Bc[(64 + n) * 16 + p] = f2bf(fre * y + fim * x); }
    }
    LDS_WAIT();
    bf16x8 Bf[8];
    const bf16x8 zero8 = (bf16x8){0, 0, 0, 0, 0, 0, 0, 0};
#pragma unroll
    for (int jt = 0; jt < 8; ++jt) Bf[jt] = q < 2 ? *(const LAS bf16x8*)(Bc + (16 * jt + r) * 16 + 8 * q) : zero8;
    LDS_WAIT();
    bf16x8 Cf[4];
    if (EMIT) {
#pragma unroll
        for (int ks = 0; ks < 4; ++ks) { const int j0 = 32 * ks + 8 * q; const bool im = j0 >= 64; const float* cp = (im ? A.c_im : A.c_re) + (size_t)(pg * 16 + r) * 64 + (j0 & 63); const float sg = im ? -1.f : 1.f;
            const f32x4 c0 = *(const f32x4*)cp, c1 = *(const f32x4*)(cp + 4); u32x4 w; w.x = pk2(sg * c0.x, sg * c0.y); w.y = pk2(sg * c0.z, sg * c0.w); w.z = pk2(sg * c1.x, sg * c1.y); w.w = pk2(sg * c1.z, sg * c1.w);
            Cf[ks] = __builtin_bit_cast(bf16x8, w); }
    }
    float hr = 0.f, hi = 0.f;
    const int ubase = ((b * 64 + g) * 2 + dir) * S5_NSEG;
    if (EMIT && seg > 0) {
        float pr = 1.f, pi = 0.f, xr = ar, xi = ai; int e = S5_LSEG;
        while (e) { if (e & 1) { const float t = pr * xr - pi * xi; pi = pr * xi + pi * xr; pr = t; } const float t2 = xr * xr - xi * xi; xi = 2.f * xr * xi; xr = t2; e >>= 1; }
        for (int s2 = 0; s2 < seg; ++s2) { const float er = E[(size_t)(ubase + s2) * 128 + n], ei = E[(size_t)(ubase + s2) * 128 + 64 + n];
            const float t = pr * hr - pi * hi + er; hi = pr * hi + pi * hr + ei; hr = t; }
    }
    const int sbeg = seg * S5_LSEG;
#define S5_ROW(pos) (dir ? rowB(b, (pos)) : rowF(b, (pos)))
#define S5_LDU(scv) (q < 2 ? *(const bf16x8*)(P + (size_t)S5_ROW(sbeg + 16 * (scv) + r) * EIN + g * 16 + 8 * q) : zero8)
    constexpr int NGRP = S5_LSEG / 64;
    LAS unsigned short* Yst = (LAS unsigned short*)(scr + 12800);
    bf16x8 un[4];
#pragma unroll
    for (int j = 0; j < 4; ++j) un[j] = S5_LDU(j);
#pragma unroll 1
    for (int grp = 0; grp < NGRP; ++grp) {
        bf16x8 uf[4];
#pragma unroll
        for (int j = 0; j < 4; ++j) uf[j] = un[j];
        if (grp + 1 < NGRP) {
#pragma unroll
            for (int j = 0; j < 4; ++j) un[j] = S5_LDU(4 * (grp + 1) + j); }
#pragma unroll
        for (int j = 0; j < 4; ++j) {
#pragma unroll
            for (int jt = 0; jt < 8; ++jt) { const f32x4 D = mfma16(uf[j], Bf[jt], (f32x4){0.f, 0.f, 0.f, 0.f});
#pragma unroll
                for (int i = 0; i < 4; ++i) BU[(4 * q + i) * 132 + 16 * jt + r] = D[i]; }
            LDS_WAIT();
            float bur[16], bui[16];
#pragma unroll
            for (int tt = 0; tt < 16; ++tt) { bur[tt] = BU[tt * 132 + n]; bui[tt] = BU[tt * 132 + 64 + n]; }
            asm volatile("" : "+v"(bur[0]), "+v"(bur[1]), "+v"(bur[2]), "+v"(bur[3]), "+v"(bur[4]), "+v"(bur[5]), "+v"(bur[6]), "+v"(bur[7]), "+v"(bur[8]), "+v"(bur[9]), "+v"(bur[10]), "+v"(bur[11]), "+v"(bur[12]), "+v"(bur[13]), "+v"(bur[14]), "+v"(bur[15]));
            asm volatile("" : "+v"(bui[0]), "+v"(bui[1]), "+v"(bui[2]), "+v"(bui[3]), "+v"(bui[4]), "+v"(bui[5]), "+v"(bui[6]), "+v"(bui[7]), "+v"(bui[8]), "+v"(bui[9]), "+v"(bui[10]), "+v"(bui[11]), "+v"(bui[12]), "+v"(bui[13]), "+v"(bui[14]), "+v"(bui[15]));
#pragma unroll
            for (int tt = 0; tt < 16; ++tt) {
                const float nhr = ar * hr - ai * hi + bur[tt], nhi = ar * hi + ai * hr + bui[tt]; hr = nhr; hi = nhi;
                if (EMIT) { Sb[tt * 136 + n] = f2bf(hr); Sb[tt * 136 + 64 + n] = f2bf(hi); } }
            if (EMIT) {
                LDS_WAIT();
                f32x4 Yv = (f32x4){0.f, 0.f, 0.f, 0.f};
#pragma unroll
                for (int ks = 0; ks < 4; ++ks) Yv = mfma16(*(const LAS bf16x8*)(Sb + r * 136 + 32 * ks + 8 * q), Cf[ks], Yv);
                LAS unsigned short* yd = Yst + (16 * j + 4 * q) * 16 + r;
#pragma unroll
                for (int i = 0; i < 4; ++i) yd[i * 16] = f2bf(Yv[i]);
            }
            LDS_WAIT();
        }
        if (EMIT) {
#pragma unroll
            for (int k = 0; k < 2; ++k) { const int chn = lane + 64 * k, tok = chn >> 1, hf = chn & 1; const u32x4 v = *(const LAS u32x4*)(Yst + tok * 16 + 8 * hf);
                *(u32x4*)(Y + (size_t)S5_ROW(sbeg + 64 * grp + tok) * 1024 + g * 16 + 8 * hf) = v; }
            LDS_WAIT();
        }
    }
    if (!EMIT) { E[(size_t)(ubase + seg) * 128 + n] = hr; E[(size_t)(ubase + seg) * 128 + 64 + n] = hi; }
}
__device__ __forceinline__ float gelu_tanh(float x) { const float z = 0.7978845608028654f * (x + 0.044715f * x * x * x); const float t = 1.f - 2.f / (__expf(2.f * z) + 1.f); return 0.5f * x * (1.f + t); }
constexpr int ATT_KP = 72, ATT_VP = 552, ATT_KBYTES = 544 * ATT_KP * 2, ATT_VBYTES = 64 * ATT_VP * 2;
static_assert(ATT_KBYTES + ATT_VBYTES <= LDS_BYTES, "attention LDS");
__device__ __forceinline__ void attn_load(int b, int kvh, int n0, const bf16_t* P1, const bf16_t* VT1, u32x4 (&kr)[9], u32x4 (&vr)[9], int tid) {
    const bf16_t* Vb = VT1 + (size_t)((b * 4 + kvh) * 64) * SL;
#pragma unroll
    for (int it = 0; it < 9; ++it) { const int idx = tid + 512 * it;
        if (idx < 4352) {
            { const int row = idx >> 3, ch = idx & 7; int grow;
              if (row < CTXL) grow = NLAT + b * CTXL + row; else { int key = n0 - 128 + (row - CTXL); key = key < 0 ? 0 : (key > SEQ - 1 ? SEQ - 1 : key); grow = b * SEQ + key; }
              kr[it] = *(const u32x4*)(P1 + (size_t)grow * OIN + 2048 + kvh * 64 + 8 * ch); }
            { const int e = idx / 68, ch = idx % 68; const int spos = ch < 32 ? 8 * ch : 128 + n0 + 8 * (ch - 32);
              vr[it] = *(const u32x4*)(Vb + (size_t)e * SL + spos); }
        } }
}
__device__ __forceinline__ void attn_store(const u32x4 (&kr)[9], const u32x4 (&vr)[9], LAS unsigned char* lds, int tid) {
#pragma unroll
    for (int it = 0; it < 9; ++it) { const int idx = tid + 512 * it;
        if (idx < 4352) {
            { const int row = idx >> 3, ch = idx & 7; *(LAS u32x4*)(lds + row * (ATT_KP * 2) + ch * 16) = kr[it]; }
            { const int e = idx / 68, ch = idx % 68; *(LAS u32x4*)(lds + ATT_KBYTES + e * (ATT_VP * 2) + ch * 16) = vr[it]; }
        } }
}
__device__ __forceinline__ void attn_unit(int b, int h, int n0, const bf16_t* P1, const float* sink, bf16_t* AO, const LAS unsigned char* lds, int lane) {
    const int r = lane & 15, q = lane >> 4;
    bf16x8 Qb[2][2];
#pragma unroll
    for (int nt = 0; nt < 2; ++nt)
#pragma unroll
        for (int ks = 0; ks < 2; ++ks) Qb[nt][ks] = ldfrag(P1 + (size_t)(b * SEQ + n0 + 16 * nt) * OIN + h * 64 + 32 * ks, OIN, r, q);
    const float snk = sink[h];
    float mrun[2] = {snk, snk}, lpart[2] = {0.f, 0.f};
    f32x4 O[2][4];
#pragma unroll
    for (int nt = 0; nt < 2; ++nt)
#pragma unroll
        for (int et = 0; et < 4; ++et) O[nt][et] = (f32x4){0.f, 0.f, 0.f, 0.f};
    const LAS unsigned char* Kl = lds + r * (ATT_KP * 2) + q * 16;
    const LAS unsigned char* Vl = lds + ATT_KBYTES + r * (ATT_VP * 2) + q * 8;
#pragma unroll 1
    for (int pr = 0; pr < 17; ++pr) {
        const bool loc = pr >= 8;
        const int m0 = loc ? n0 - 128 + 32 * (pr - 8) : 32 * pr;
        bf16x8 Kf[2][2];
#pragma unroll
        for (int kt = 0; kt < 2; ++kt)
#pragma unroll
            for (int ks = 0; ks < 2; ++ks) Kf[kt][ks] = *(const LAS bf16x8*)(Kl + (pr * 32 + 16 * kt) * (ATT_KP * 2) + ks * 64);
        bf16x8 Vf[4];
#pragma unroll
        for (int et = 0; et < 4; ++et) { const LAS unsigned char* vr = Vl + (16 * et) * (ATT_VP * 2) + pr * 64; const u32x2 lo = *(const LAS u32x2*)vr, hi = *(const LAS u32x2*)(vr + 32);
            u32x4 aw; aw.x = lo.x; aw.y = lo.y; aw.z = hi.x; aw.w = hi.y; Vf[et] = __builtin_bit_cast(bf16x8, aw); }
#pragma unroll
        for (int nt = 0; nt < 2; ++nt) {
            f32x4 S[2];
#pragma unroll
            for (int kt = 0; kt < 2; ++kt) { S[kt] = mfma16(Kf[kt][0], Qb[nt][0], (f32x4){0.f, 0.f, 0.f, 0.f}); S[kt] = mfma16(Kf[kt][1], Qb[nt][1], S[kt]); }
            if (loc) { const int qn = n0 + 16 * nt + r;
#pragma unroll
                for (int kt = 0; kt < 2; ++kt)
#pragma unroll
                    for (int i = 0; i < 4; ++i) { const int key = m0 + 16 * kt + 4 * q + i; const int d = key - qn; const bool ok = (d <= 128) && (d >= -128) && (key >= 0) && (key < SEQ); S[kt][i] = ok ? S[kt][i] : -1e30f; } }
            float tm = fmaxf(fmaxf(fmaxf(S[0][0], S[0][1]), fmaxf(S[0][2], S[0][3])), fmaxf(fmaxf(S[1][0], S[1][1]), fmaxf(S[1][2], S[1][3])));
            tm = fmaxf(tm, __shfl_xor(tm, 16)); tm = fmaxf(tm, __shfl_xor(tm, 32));
            const float mn = fmaxf(mrun[nt], tm), f = __expf(mrun[nt] - mn); mrun[nt] = mn;
            float p[8]; float ps = 0.f;
#pragma unroll
            for (int kt = 0; kt < 2; ++kt)
#pragma unroll
                for (int i = 0; i < 4; ++i) { p[kt * 4 + i] = __expf(S[kt][i] - mn); ps += p[kt * 4 + i]; }
            lpart[nt] = lpart[nt] * f + ps;
            u32x4 pw; pw.x = pk2(p[0], p[1]); pw.y = pk2(p[2], p[3]); pw.z = pk2(p[4], p[5]); pw.w = pk2(p[6], p[7]);
            const bf16x8 pb = __builtin_bit_cast(bf16x8, pw);
#pragma unroll
            for (int et = 0; et < 4; ++et) { O[nt][et] = O[nt][et] * f; O[nt][et] = mfma16(Vf[et], pb, O[nt][et]); }
        }
    }
#pragma unroll
    for (int nt = 0; nt < 2; ++nt) {
        float l = lpart[nt]; l += __shfl_xor(l, 16); l += __shfl_xor(l, 32); l += __expf(snk - mrun[nt]);
        const float rl = 1.f / l; const int row = b * SEQ + n0 + 16 * nt + r;
#pragma unroll
        for (int et = 0; et < 4; ++et) { u32x2 w; w.x = pk2(O[nt][et][0] * rl, O[nt][et][1] * rl); w.y = pk2(O[nt][et][2] * rl, O[nt][et][3] * rl);
            *(u32x2*)(AO + (size_t)row * DM + h * 64 + 16 * et + 4 * q) = w; }
    }
}
__global__ void __launch_bounds__(512, 2) fwd_megakernel(Args A) {
    extern __shared__ __attribute__((aligned(16))) unsigned char lds_raw[];
    cg::grid_group grid = cg::this_grid();
    LAS unsigned char* lds = (LAS unsigned char*)lds_raw;
    const int bid = blockIdx.x, G = gridDim.x, NGW = G * 8, NGT = G * 512;
    const int wave0 = __builtin_amdgcn_readfirstlane((int)threadIdx.x >> 6);
#define PH() unsigned om_ = ~0u; asm volatile("" : "+s"(om_)); const int tid = wave0 * 64 + (int)__builtin_amdgcn_mbcnt_hi(om_, __builtin_amdgcn_mbcnt_lo(om_, 0u)), lane = tid & 63, wave = wave0, gw = bid * 8 + wave, gtid = bid * 512 + tid; \
    LAS unsigned char* wscr = lds + wave * 16384; (void)lane; (void)gw; (void)gtid; (void)wscr
    unsigned char* ws = A.ws;
    float* MOD = (float*)(ws + WS_MOD); float* ROPE = (float*)(ws + WS_ROPE); float* S5E = (float*)(ws + WS_S5E); float* XC = (float*)(ws + WS_XC);
    bf16_t* XN = (bf16_t*)(ws + WS_XN);
    bf16_t* P = (bf16_t*)(ws + WS_P); bf16_t* B2 = (bf16_t*)(ws + WS_B2); bf16_t* KTF = (bf16_t*)(ws + WS_KTF); bf16_t* KTB = (bf16_t*)(ws + WS_KTB); bf16_t* LOC = (bf16_t*)(ws + WS_LOC); bf16_t* A2 = (bf16_t*)(ws + WS_A2); bf16_t* ORET = (bf16_t*)(ws + WS_ORET);
    bf16_t* YF = (bf16_t*)(ws + WS_YF); bf16_t* YB = (bf16_t*)(ws + WS_YB); bf16_t* YG = (bf16_t*)(ws + WS_YG);
    bf16_t* O1 = (bf16_t*)(ws + WS_O1); bf16_t* HB = (bf16_t*)(ws + WS_HB); bf16_t* O2 = (bf16_t*)(ws + WS_O2); bf16_t* O1C = (bf16_t*)(ws + WS_O1C); bf16_t* O2C = (bf16_t*)(ws + WS_O2C);
    bf16_t* P1 = (bf16_t*)(ws + WS_P1); bf16_t* VT1 = (bf16_t*)(ws + WS_VT1); bf16_t* AO = (bf16_t*)(ws + WS_AO); bf16_t* O1B = (bf16_t*)(ws + WS_O1B);
    volatile LAS unsigned* xb_st = (volatile LAS unsigned*)(lds + 148992);
    if (threadIdx.x == 0) { xb_st[0] = 0u; xb_st[1] = 0u; }
    __syncthreads();
    const XcdBarrier xbar = xcd_barrier_post((unsigned*)(ws + WS_BAR), xb_st);
#define GSYNC_CG() do { asm volatile("s_waitcnt vmcnt(0) lgkmcnt(0)" ::: "memory"); grid.sync(); } while (0)
#define GSYNC() do { xcd_barrier(xbar); } while (0)
#ifdef PROBE_A
    unsigned long long pr_prev = __builtin_amdgcn_s_memrealtime(), pr_t0 = pr_prev, pr_a = 0, pr_b = 0;
#define STAMP(cls) do { const unsigned long long now_ = __builtin_amdgcn_s_memrealtime(); if ((cls) == PROBE_A) pr_a += now_ - pr_prev; if ((cls) == PROBE_B) pr_b += now_ - pr_prev; pr_prev = now_; } while (0)
#else
#define STAMP(cls) do { } while (0)
#endif
#define MODV(L, k6, r) (MOD + (((L) * 6 + (k6)) * 5 + (r)) * DM)
#define NG(L, k) (A.norm_g + ((L) * 4 + (k)) * DM)
#define GEMM(MODE, Aptr, Bptr, Mv, Nv, Kv, Optr, ldcv, lo, hi, scv, ygp, ldyv, biasp) do { \
        pg8::Gemm g_{(Kv), (Kv), (Kv)}; pg8::StaticOrder S_; S_.init((Aptr), (Bptr), (Mv), (Nv), (Kv), (Kv), G, bid); \
        pg8::EpiX<MODE> E_{(Optr), (ldcv), (lo), (hi), (scv), (ygp), (ldyv), (biasp), 0}; \
        pg8::gemm_phase<pg8::EpiX<MODE>, pg8::StaticOrder, true, true>(lds, g_, S_, E_, wave0); } while (0)
#define CGEMM(Aptr, Bptr, Kfull, Optr) do { \
        int kv_ = (Kfull) / 8; asm volatile("" : "+s"(kv_)); pg8::Gemm g_{kv_, (Kfull), (Kfull)}; pg8::CtxOrder S_{G, bid, (const char*)(Aptr), (const char*)(Bptr), (Kfull), (Kfull), 8, 8, (Kfull) / 8}; \
        pg8::EpiX<0> E_{(Optr), DM, 0, 0, 1.f, nullptr, 0, nullptr, (size_t)NCTX * DM}; \
        pg8::gemm_phase<pg8::EpiX<0>, pg8::CtxOrder, true, true>(lds, g_, S_, E_, wave0); } while (0)
#define RGEMM(KIND, MODE, Kv, ldav, ldbv, Optr, ldcv, zsv) do { \
        int kv_ = (Kv); asm volatile("" : "+s"(kv_)); pg8::Gemm g_{kv_, (ldav), (ldbv)}; pg8::RetOrder<KIND> S_{G, bid, (const char*)P, (const char*)B2, (const char*)A2, (const char*)KTF, (const char*)KTB}; \
        pg8::EpiX<MODE> E_{(Optr), (ldcv), 0, 0, 1.f, nullptr, 0, nullptr, (size_t)(zsv)}; \
        pg8::gemm_phase<pg8::EpiX<MODE>, pg8::RetOrder<KIND>, true, true>(lds, g_, S_, E_, wave0); } while (0)

    { PH();
    phase_mod(A, MOD, (LAS float*)lds, tid, wave, lane, bid, G);
    phase_wconv(A, ws, (LAS float*)wscr, gw, NGW, lane);
    for (int i = gtid; i < 1024; i += NGT) { const int pos = i >> 4, f = i & 15; const float inv = exp2f(-(float)f * (13.287712379549449f / 16.f)); float sn, cs; sincosf((float)pos * inv, &sn, &cs); ROPE[2 * i] = cs; ROPE[2 * i + 1] = sn; }
    }
    if (ws == nullptr) grid.sync();
    GSYNC(); STAMP(0);
    { PH();
    for (int row = gw; row < NTOK; row += NGW) { const int mr = row < NLAT ? row / SEQ : 4; const float* xs = row < NLAT ? A.x + (size_t)row * DM : A.ctx + (size_t)(row - NLAT) * DM;
        row_pass(xs, nullptr, nullptr, nullptr, nullptr, NG(0, 0), MODV(0, 0, mr), MODV(0, 1, mr), XN + (size_t)row * DM, lane); }
    }
    GSYNC(); STAMP(1);
    { PH();
    GEMM(0, XN, ws + WS_WIN0, NTOK, EIN, DM, P, EIN, 2048, 3072, 0.0625f, nullptr, 0, nullptr);
    }
    GSYNC(); STAMP(2);
    { PH();
    for (int it = gw; it < NB * 3 * 16 * 68; it += NGW) { int t = it; const int sc = t % 68; t /= 68; const int cb = t % 16; t /= 16; const int which = t % 3; const int b = t / 3; const int h = cb >> 2;
        const int s0 = 64 * sc;
        if (which == 0) tr_item(P, EIN, 3072 + 64 * cb, b, s0, B2 + ((size_t)(((b * 4 + h) * 17 + (s0 >> 8)) * 256 + (cb & 3) * 64)) * 768 + (s0 & 255), 768, 0, 0.f, (LAS unsigned short*)wscr, lane);
        else tr_item(P, EIN, 2048 + 64 * cb, b, s0, (which == 1 ? KTF : KTB) + (size_t)(b * 1024 + 64 * cb) * SL + s0, SL, which, which == 1 ? ret_lg2(h, 0) : ret_lg2(h, 1), (LAS unsigned short*)wscr, lane); }
    for (int vb = bid; vb < 256; vb += G) { const int seg = vb & 3, dir = (vb >> 2) & 1, b = (vb >> 3) & 3, g = (vb >> 5) * 8 + wave;
        s5_scan<false>(A, b, g, dir, seg, P, S5E, nullptr, wscr, lane); }
    }
    GSYNC(); STAMP(5);
    { PH();
    RGEMM(1, 0, 256, 768, SL, LOC, 256, 65536);
    }
    GSYNC(); STAMP(6);
    { PH();
    for (int i = gtid; i < 32 * 8192; i += NGT) { const int bhd = i >> 13, e8 = (i & 8191) * 8; const int bh = bhd >> 1, h = bh & 3, dir = bhd & 1; const int e = e8 >> 8, d = e8 & 255;
        const float gT = exp2f(256.f * ret_lg2(h, dir)); const bf16_t* src = LOC + (size_t)(bhd * 16) * 65536 + e8;
        float run[8] = {0.f, 0.f, 0.f, 0.f, 0.f, 0.f, 0.f, 0.f};
        for (int pc = 0; pc < 17; ++pc) { const int cc = dir ? (pc == 0 ? 0 : 17 - pc) : pc;
            u32x4 o; o.x = pk2(run[0], run[1]); o.y = pk2(run[2], run[3]); o.z = pk2(run[4], run[5]); o.w = pk2(run[6], run[7]);
            *(u32x4*)(B2 + ((size_t)((bh * 17 + cc) * 256 + e)) * 768 + 256 + 256 * dir + d) = o;
            if (pc < 16) { const u32x4 w = *(const u32x4*)(src + (size_t)pc * 65536);
                run[0] = gT * run[0] + bflo(w.x); run[1] = gT * run[1] + bfhi(w.x); run[2] = gT * run[2] + bflo(w.y); run[3] = gT * run[3] + bfhi(w.y);
                run[4] = gT * run[4] + bflo(w.z); run[5] = gT * run[5] + bfhi(w.z); run[6] = gT * run[6] + bflo(w.w); run[7] = gT * run[7] + bfhi(w.w); } } }
    }
    GSYNC(); STAMP(7);
    { PH();
    for (int i = gtid; i < NTOK * 4 * 32; i += NGT) { const int d8 = (i & 31) * 8, h = (i >> 5) & 3, row = i >> 7; const int in = row & 255;
        const int b = row < NLAT ? row / SEQ : (row - NLAT) / CTXL, cc = row < NLAT ? 1 + ((row & (SEQ - 1)) >> 8) : 0;
        const u32x4 w = *(const u32x4*)(P + (size_t)row * EIN + 1024 + h * 256 + d8);
        const float sf = exp2f((float)(in + 1) * ret_lg2(h, 0)), sb = exp2f((float)(256 - in) * ret_lg2(h, 1));
        bf16_t* dst = A2 + ((size_t)(((b * 4 + h) * 17 + cc) * 256 + in)) * 768 + 256 + d8;
        u32x4 o; o.x = pk2(bflo(w.x) * sf, bfhi(w.x) * sf); o.y = pk2(bflo(w.y) * sf, bfhi(w.y) * sf); o.z = pk2(bflo(w.z) * sf, bfhi(w.z) * sf); o.w = pk2(bflo(w.w) * sf, bfhi(w.w) * sf);
        *(u32x4*)dst = o;
        o.x = pk2(bflo(w.x) * sb, bfhi(w.x) * sb); o.y = pk2(bflo(w.y) * sb, bfhi(w.y) * sb); o.z = pk2(bflo(w.z) * sb, bfhi(w.z) * sb); o.w = pk2(bflo(w.w) * sb, bfhi(w.w) * sb);
        *(u32x4*)(dst + 256) = o; }
    RGEMM(2, 3, 256, EIN, EIN, A2, 768, 256 * 768);
    }
    GSYNC(); STAMP(8);
    { PH();
    RGEMM(3, 4, 768, 768, 768, ORET, 1024, 0);
    }
    GSYNC(); STAMP(8);
    { PH();
    for (int it = gw; it < NTOK * 4; it += NGW) { const int h = it & 3, row = it >> 2;
        const u32x2 ow = *(const u32x2*)(ORET + (size_t)row * 1024 + h * 256 + 4 * lane); const float o0 = bflo(ow.x), o1 = bfhi(ow.x), o2 = bflo(ow.y), o3 = bfhi(ow.y);
        const float ss = wave_sum((o0 * o0 + o1 * o1) + (o2 * o2 + o3 * o3)); const float rinv = 1.0f / sqrtf(ss * (1.f / 256.f) + EPS);
        const u32x2 gw2 = *(const u32x2*)(P + (size_t)row * EIN + 4096 + h * 256 + 4 * lane); const float g0 = bflo(gw2.x), g1 = bfhi(gw2.x), g2 = bflo(gw2.y), g3 = bfhi(gw2.y);
        u32x2 w; w.x = pk2(o0 * rinv * (g0 / (1.f + __expf(-g0))), o1 * rinv * (g1 / (1.f + __expf(-g1)))); w.y = pk2(o2 * rinv * (g2 / (1.f + __expf(-g2))), o3 * rinv * (g3 / (1.f + __expf(-g3))));
        *(u32x2*)(XN + (size_t)row * DM + 1024 + h * 256 + 4 * lane) = w; }
    for (int vb = bid; vb < 256; vb += G) { const int seg = vb & 3, dir = (vb >> 2) & 1, b = (vb >> 3) & 3, g = (vb >> 5) * 8 + wave;
        s5_scan<true>(A, b, g, dir, seg, P, S5E, dir ? YB : YF, wscr, lane); }
    }
    GSYNC(); STAMP(9);
    { PH();
    for (int i = gtid; i < NTOK * 128; i += NGT) { const int row = i >> 7, col = (i & 127) * 8;
        const u32x4 a = *(const u32x4*)(YF + (size_t)row * 1024 + col), bq = *(const u32x4*)(YB + (size_t)row * 1024 + col), u = *(const u32x4*)(P + (size_t)row * EIN + col);
        const f32x4 d0 = *(const f32x4*)(A.s5_d + col), d1 = *(const f32x4*)(A.s5_d + col + 4);
        float v[8] = {bflo(a.x) + bflo(bq.x) + d0.x * bflo(u.x), bfhi(a.x) + bfhi(bq.x) + d0.y * bfhi(u.x), bflo(a.y) + bflo(bq.y) + d0.z * bflo(u.y), bfhi(a.y) + bfhi(bq.y) + d0.w * bfhi(u.y),
                      bflo(a.z) + bflo(bq.z) + d1.x * bflo(u.z), bfhi(a.z) + bfhi(bq.z) + d1.y * bfhi(u.z), bflo(a.w) + bflo(bq.w) + d1.z * bflo(u.w), bfhi(a.w) + bfhi(bq.w) + d1.w * bfhi(u.w)};
        u32x4 o; o.x = pk2(gelu_tanh(v[0]), gelu_tanh(v[1])); o.y = pk2(gelu_tanh(v[2]), gelu_tanh(v[3])); o.z = pk2(gelu_tanh(v[4]), gelu_tanh(v[5])); o.w = pk2(gelu_tanh(v[6]), gelu_tanh(v[7]));
        *(u32x4*)(YG + (size_t)row * 1024 + col) = o; }
    }
    GSYNC(); STAMP(9);
    { PH();
    GEMM(2, YG, ws + WS_GLU, NTOK, 1024, 1024, XN, DM, 0, 0, 1.f, YG, 1024, A.glu_b);
    }
    GSYNC(); STAMP(2);
    { PH();
    GEMM(0, XN, ws + WS_WOUT0, NLAT, DM, DM, O1, DM, 0, 0, 1.f, nullptr, 0, nullptr);
    CGEMM(XN + (size_t)NLAT * DM, ws + WS_WOUT0, DM, O1C);
    }
    GSYNC(); STAMP(2);
    { PH();
    for (int row = gw; row < NTOK; row += NGW) { const int mr = row < NLAT ? row / SEQ : 4; const float* xs = row < NLAT ? A.x + (size_t)row * DM : A.ctx + (size_t)(row - NLAT) * DM;
        float* xd = row < NLAT ? A.out + (size_t)row * DM : XC + (size_t)(row - NLAT) * DM;
        const bool cx = row >= NLAT;
        row_pass(xs, cx ? O1C + (size_t)(row - NLAT) * DM : O1 + (size_t)row * DM, MODV(0, 2, mr), NG(0, 1), xd, NG(0, 2), MODV(0, 3, mr), MODV(0, 4, mr), XN + (size_t)row * DM, lane, cx ? 8 : 1, (size_t)NCTX * DM); }
    }
    GSYNC(); STAMP(1);
    { PH();
    GEMM(1, XN, ws + WS_W1_0, NTOK, FF, DM, HB, FF, 0, 0, 1.f, nullptr, 0, nullptr);
    }
    GSYNC(); STAMP(2);
    { PH();
    GEMM(0, HB, ws + WS_W2_0, NLAT, DM, FF, O2, DM, 0, 0, 1.f, nullptr, 0, nullptr);
    CGEMM(HB + (size_t)NLAT * FF, ws + WS_W2_0, FF, O2C);
    }
    GSYNC(); STAMP(2);
    { PH();
    for (int row = gw; row < NTOK; row += NGW) { const int mr = row < NLAT ? row / SEQ : 4; float* xd = row < NLAT ? A.out + (size_t)row * DM : XC + (size_t)(row - NLAT) * DM;
        const bool cx = row >= NLAT;
        row_pass(xd, cx ? O2C + (size_t)(row - NLAT) * DM : O2 + (size_t)row * DM, MODV(0, 5, mr), NG(0, 3), xd, NG(1, 0), MODV(1, 0, mr), MODV(1, 1, mr), XN + (size_t)row * DM, lane, cx ? 8 : 1, (size_t)NCTX * DM); }
    }
    GSYNC(); STAMP(1);
    { PH();
    GEMM(5, XN, ws + WS_WIN1, NTOK, OIN, DM, P1, OIN, 0, 0, 1.f, nullptr, 0, ROPE);
    }
    GSYNC(); STAMP(2);
    { PH();
    for (int it = gw; it < NB * 4 * 68; it += NGW) { int t = it; const int sc = t % 68; t /= 68; const int cb = t % 4; const int b = t / 4;
        tr_item(P1, OIN, 2304 + 64 * cb, b, 64 * sc, VT1 + (size_t)(b * 256 + 64 * cb) * SL + 64 * sc, SL, 0, 0.f, (LAS unsigned short*)wscr, lane); }
    }
    GSYNC(); STAMP(4);
    { PH();
    { u32x4 kr[9], vr[9];
      if (bid < NB * 4 * 128) attn_load(bid / 512, (bid / 128) % 4, 32 * (bid % 128), P1, VT1, kr, vr, tid);
      for (int vb = bid; vb < NB * 4 * 128; vb += G) { const int qg = vb % 128; const int kvh = (vb / 128) % 4; const int b = vb / 512;
        attn_store(kr, vr, lds, tid);
        __syncthreads();
        { const int nb = vb + G; if (nb < NB * 4 * 128) attn_load(nb / 512, (nb / 128) % 4, 32 * (nb % 128), P1, VT1, kr, vr, tid); }
        attn_unit(b, kvh * 8 + wave, 32 * qg, P1, A.odd_sink, AO, lds, lane);
        __syncthreads(); } }
    }
    GSYNC(); STAMP(4);
    { PH();
    GEMM(0, AO, ws + WS_WOUT1, NLAT, DM, DM, O1B, DM, 0, 0, 1.f, nullptr, 0, nullptr);
    }
    GSYNC(); STAMP(2);
    { PH();
    for (int row = gw; row < NLAT; row += NGW) { const int mr = row / SEQ; float* xd = A.out + (size_t)row * DM;
        row_pass(xd, O1B + (size_t)row * DM, MODV(1, 2, mr), NG(1, 1), xd, NG(1, 2), MODV(1, 3, mr), MODV(1, 4, mr), XN + (size_t)row * DM, lane); }
    }
    GSYNC(); STAMP(1);
    { PH();
    GEMM(1, XN, ws + WS_W1_1, NLAT, FF, DM, HB, FF, 0, 0, 1.f, nullptr, 0, nullptr);
    }
    GSYNC(); STAMP(2);
    { PH();
    GEMM(0, HB, ws + WS_W2_1, NLAT, DM, FF, O2, DM, 0, 0, 1.f, nullptr, 0, nullptr);
    }
    GSYNC(); STAMP(2);
    { PH();
    for (int row = gw; row < NLAT; row += NGW) { const int mr = row / SEQ; float* xd = A.out + (size_t)row * DM;
        row_pass(xd, O2 + (size_t)row * DM, MODV(1, 5, mr), NG(1, 3), xd, nullptr, nullptr, nullptr, nullptr, lane); }
    }
#ifdef PROBE_SYNC
    for (int i_ = 0; i_ < 40; ++i_) GSYNC();
#endif
#ifdef PROBE_A
    GSYNC(); STAMP(1);
    { PH(); unsigned long long* lk = (unsigned long long*)(ws + WS_S5E);
      if (bid == 0 && tid == 0) { lk[0] = pr_a; lk[1] = pr_prev - pr_t0; const unsigned long long t1 = __builtin_amdgcn_s_memrealtime(); while (__builtin_amdgcn_s_memrealtime() - t1 < 4ull * pr_b) __builtin_amdgcn_s_sleep(8); }
      GSYNC();
      const double fr = (double)lk[0] / (double)lk[1]; const int K = (int)(fr * 2000000.0);
      for (int i = gtid; i < K; i += NGT) A.out[(size_t)i * 16 + 5] += 0.05f; }
#endif
}

extern "C" void kernel_launch(void* const* d_in, const int* in_sizes, int n_in, void* d_out, int out_size, void* d_ws, size_t ws_size, hipStream_t stream) {
    static int grid = 0;
    if (grid == 0) {
        if (n_in != 24 || ws_size < WS_END) { fprintf(stderr, "kernel_launch: unexpected n_in %d / ws_size %zu (need %zu)\n", n_in, ws_size, (size_t)WS_END); grid = -1; return; }
        int dev = 0, cus = 0, per_cu = 0;
        (void)hipGetDevice(&dev); (void)hipDeviceGetAttribute(&cus, hipDeviceAttributeMultiprocessorCount, dev);
        (void)hipFuncSetAttribute((const void*)fwd_megakernel, hipFuncAttributeMaxDynamicSharedMemorySize, LDS_BYTES);
        if (hipOccupancyMaxActiveBlocksPerMultiprocessor(&per_cu, (const void*)fwd_megakernel, 512, LDS_BYTES) != hipSuccess || per_cu < 1) per_cu = 1;
        (void)hipGetLastError();
        grid = cus * 1;
    }
    if (grid < 0) return;
    (void)hipMemsetAsync((unsigned char*)d_ws + WS_BAR, 0, 16384, stream);
    Args a{};
    const float** f = (const float**)&a;
    for (int i = 0; i < 24; ++i) f[i] = (const float*)d_in[i];
    a.out = (float*)d_out; a.ws = (unsigned char*)d_ws;
    void* args[] = {&a};
    hipError_t e = hipLaunchCooperativeKernel((const void*)fwd_megakernel, dim3(grid), dim3(512), args, LDS_BYTES, stream);
    if (e != hipSuccess) fprintf(stderr, "cooperative launch failed: %s (grid %d)\n", hipGetErrorString(e), grid);
}
```

```cpp
#include <hip/hip_runtime.h>
#include <hip/hip_cooperative_groups.h>
#include <cstdio>
#include <cstdint>
namespace cg = cooperative_groups;
constexpr int DM = 2048, NB = 4, SEQ = 4096, CTXL = 256, NLAT = NB * SEQ, NCTX = NB * CTXL, NTOK = NLAT + NCTX, SL = SEQ + CTXL;
constexpr int FF = 8192, EIN = 5120, OIN = 2560;
constexpr float EPS = 1e-6f;
constexpr size_t MiB = 1u << 20;
constexpr size_t WS_WIN0 = 0, WS_GLU = 20 * MiB, WS_WOUT0 = 22 * MiB, WS_W1_0 = 30 * MiB, WS_W2_0 = 62 * MiB, WS_WIN1 = 94 * MiB, WS_WOUT1 = 104 * MiB, WS_W1_1 = 112 * MiB, WS_W2_1 = 144 * MiB;
constexpr size_t WS_XN = 176 * MiB;
constexpr size_t WS_MOD = 244 * MiB, WS_ROPE = 245 * MiB, WS_S5E = 246 * MiB, WS_XC = 247 * MiB;
constexpr size_t WS_BAR = 244 * MiB + 768 * 1024;
constexpr size_t WS_BIG = 256 * MiB;
constexpr size_t WS_P = WS_BIG, WS_B2 = WS_BIG + 170 * MiB, WS_KTF = WS_BIG + 272 * MiB, WS_KTB = WS_BIG + 306 * MiB, WS_LOC = WS_XN  , WS_A2 = WS_BIG + 272 * MiB, WS_ORET = WS_BIG + 374 * MiB;
constexpr size_t WS_YF = WS_BIG + 272 * MiB, WS_YB = WS_BIG + 306 * MiB, WS_YG = WS_B2;
constexpr size_t WS_O1 = WS_BIG, WS_HB = WS_BIG, WS_O2 = WS_BIG + 272 * MiB;
constexpr size_t WS_O1C = WS_BIG + 68 * MiB, WS_O2C = WS_BIG + 340 * MiB;
constexpr size_t WS_P1 = WS_BIG, WS_VT1 = WS_BIG + 88 * MiB, WS_AO = WS_BIG + 100 * MiB, WS_O1B = WS_BIG + 170 * MiB;
constexpr size_t WS_END = WS_BIG + 408 * MiB;
constexpr int LDS_BYTES = 155648;
__device__ __forceinline__ int rowF(int b, int s) { return s < CTXL ? NLAT + b * CTXL + s : b * SEQ + (s - CTXL); }
__device__ __forceinline__ int rowB(int b, int s) { return s < CTXL ? NLAT + b * CTXL + (CTXL - 1 - s) : b * SEQ + (SEQ - 1 - (s - CTXL)); }
__device__ __forceinline__ float ret_lg2(int h, int dir) {
    const float x = exp2f(-5.f - 2.f * (float)h - (float)dir);
    const float l = -x * (1.f + x * (0.5f + x * (1.f / 3.f + x * (0.25f + x * (0.2f + x * (1.f / 6.f + x * (1.f / 7.f)))))));
    return l * 1.4426950408889634f;
}
namespace pg8 {
#define PG8_LAS __attribute__((address_space(3)))
typedef unsigned short bf16_t;
typedef short bf16x8 __attribute__((ext_vector_type(8)));
typedef float f32x4 __attribute__((ext_vector_type(4)));
typedef unsigned u32x4 __attribute__((ext_vector_type(4)));
constexpr int BM = 256, BK = 64, HALF = 128, HTB = HALF * BK * 2  , STAGE_BYTES = 8 * HTB, NXCD = 8, WGM = 4;

__host__ __device__ __forceinline__ int lds_byte(int r, int c) { const int st = (r >> 4) * 2 + (c >> 5), rr = r & 15, cc = c & 31, ob = rr * 64 + cc * 2; return st * 1024 + (ob ^ (((ob >> 9) & 1) << 5)); }
__host__ __device__ __forceinline__ void stage_rc(int b, int& R, int& C) { const int st = b / 1024, sb = b % 1024, swz = sb ^ (((sb >> 9) & 1) << 5); R = (st >> 1) * 16 + swz / 64; C = (st & 1) * 32 + (swz % 64) / 2; }
__host__ __device__ __forceinline__ int perm32(int rho) { const int n = rho >> 4, i = rho & 15; return 8 * (i >> 2) + 4 * n + (i & 3); }

struct Unit { int pm, pn, z; const char* a; const char* b; };
struct Gemm { int K, lda, ldb; };

struct StaticOrder {
    int nM, nN, nwg, G, c; const char* A; const char* B; size_t tsa, tsb;
    __host__ __device__ void init(const void* A_, const void* B_, int M, int N, int lda, int ldb, int G_, int c_) { nM = M / BM; nN = N / BM; nwg = nM * nN; G = G_; c = c_; A = (const char*)A_; B = (const char*)B_; tsa = (size_t)BM * lda * 2; tsb = (size_t)BM * ldb * 2; }
    __host__ __device__ bool next(int i, Unit& u) const {
        const long L = (long)i * G + c; if (L >= nwg) return false;
        int wgid = (int)L; { const int q = nwg / NXCD, r = nwg % NXCD, xcd = wgid % NXCD, off = wgid / NXCD; wgid = (xcd < r ? xcd * (q + 1) : r * (q + 1) + (xcd - r) * q) + off; }
        const int nig = WGM * nN, gid = wgid / nig, fm = gid * WGM, gsz = (nM - fm) < WGM ? (nM - fm) : WGM;
        u.pm = fm + ((wgid % nig) % gsz); u.pn = (wgid % nig) / gsz; u.z = 0; u.a = A + (size_t)u.pm * tsa; u.b = B + (size_t)u.pn * tsb; return true;
    }
    __device__ __forceinline__ void a_ready(const Unit&) const {}
    __device__ __forceinline__ void done(const Unit&) const {}
};

typedef float f32x2 __attribute__((ext_vector_type(2))); typedef __bf16 bf16x2v __attribute__((ext_vector_type(2)));
__device__ __forceinline__ unsigned cvt_pk_bf16(float lo, float hi) { f32x2 v = {lo, hi}; bf16x2v b = __builtin_convertvector(v, bf16x2v); return __builtin_bit_cast(unsigned, b); }
__device__ __forceinline__ float bf_lo(unsigned w) { return __uint_as_float(w << 16); }
__device__ __forceinline__ float bf_hi(unsigned w) { return __uint_as_float(w & 0xffff0000u); }
template <int MODE> struct EpiX {
    static constexpr bool PERM = true, AFTER_DRAIN = false;
    bf16_t* O; int ldc; int sc_lo, sc_hi; float sc; const bf16_t* yg; int ldy; const float* bias; size_t zs;
    __device__ __forceinline__ void operator()(const f32x4 (&acc)[2][2][4][2], const Unit& u, int wr, int wc, int fr, int fq) const {
        const int row0 = u.pm * BM + wr * 64 + fr; const int colt = u.pn * BM; const int col0 = colt + wc * 32 + 8 * fq;
        float s = 1.f; if (MODE == 0) { if (colt >= sc_lo && colt < sc_hi) s = sc; }
        bf16_t* Ob = O + (size_t)u.z * zs;
        float lgf = 0.f, lgb = 0.f;
        int zz = 0;
        if (MODE == 3) { const int h = (u.z / 17) & 3; lgf = ::ret_lg2(h, 0); lgb = ::ret_lg2(h, 1); asm volatile("" : "+v"(zz)); }
        if (MODE == 4) { const int b = u.z / 68, h = (u.z / 17) & 3, c = u.z % 17; Ob = O + (size_t)::rowF(b, 256 * c) * 1024 + h * 256; }
#pragma unroll
        for (int ai = 0; ai < 2; ++ai)
#pragma unroll
            for (int m = 0; m < 4; ++m) { const int row = row0 + ai * HALF + m * 16;
#pragma unroll
                for (int bj = 0; bj < 2; ++bj) { const int col = col0 + bj * HALF; f32x4 v0 = acc[ai][bj][m][0], v1 = acc[ai][bj][m][1];
                    if (MODE == 0) { v0 = v0 * s; v1 = v1 * s; }
                    if (MODE == 5) { if (colt < 2304 && u.pm < ::NLAT / 256) {
                        const float qs = colt < 2048 ? 0.125f : 1.f; const int tok = row & (::SEQ - 1); const int j0 = (col & 63) >> 1;
                        const int pos = j0 < 16 ? (tok >> 6) : (tok & 63); const float* rp = bias + 2 * (pos * 16 + (j0 & 15));
                        const f32x4 t0 = *(const f32x4*)rp, t1 = *(const f32x4*)(rp + 4);
                        const f32x4 a = v0, b = v1;
                        v0[0] = (a[0] * t0[0] - a[1] * t0[1]) * qs; v0[1] = (a[1] * t0[0] + a[0] * t0[1]) * qs; v0[2] = (a[2] * t0[2] - a[3] * t0[3]) * qs; v0[3] = (a[3] * t0[2] + a[2] * t0[3]) * qs;
                        v1[0] = (b[0] * t1[0] - b[1] * t1[1]) * qs; v1[1] = (b[1] * t1[0] + b[0] * t1[1]) * qs; v1[2] = (b[2] * t1[2] - b[3] * t1[3]) * qs; v1[3] = (b[3] * t1[2] + b[2] * t1[3]) * qs; }
                        else { v0 = v0 * s; v1 = v1 * s; } }
                    if (MODE == 3) {
#pragma unroll
                        for (int e2 = 0; e2 < 4; ++e2) { const float d0 = (float)(row - col - e2 + zz), d1 = d0 - 4.f;
                            v0[e2] *= (d0 >= 0.f ? exp2f(d0 * lgf) : 0.f) + (d0 <= 0.f ? exp2f(-d0 * lgb) : 0.f);
                            v1[e2] *= (d1 >= 0.f ? exp2f(d1 * lgf) : 0.f) + (d1 <= 0.f ? exp2f(-d1 * lgb) : 0.f); } }
                    if (MODE == 1) {
#pragma unroll
                        for (int e = 0; e < 4; ++e) { float a = fmaxf(v0[e], 0.f), b = fmaxf(v1[e], 0.f); v0[e] = a * a; v1[e] = b * b; } }
                    if (MODE == 2) { const f32x4 b0 = *(const f32x4*)(bias + col), b1 = *(const f32x4*)(bias + col + 4);
                        const u32x4 y = *(const u32x4*)(yg + (size_t)row * ldy + col);
                        float yf[8] = {bf_lo(y.x), bf_hi(y.x), bf_lo(y.y), bf_hi(y.y), bf_lo(y.z), bf_hi(y.z), bf_lo(y.w), bf_hi(y.w)};
#pragma unroll
                        for (int e = 0; e < 4; ++e) { v0[e] = yf[e] / (1.f + __expf(-(v0[e] + b0[e]))); v1[e] = yf[4 + e] / (1.f + __expf(-(v1[e] + b1[e]))); } }
                    u32x4 w; w.x = cvt_pk_bf16(v0[0], v0[1]); w.y = cvt_pk_bf16(v0[2], v0[3]); w.z = cvt_pk_bf16(v1[0], v1[1]); w.w = cvt_pk_bf16(v1[2], v1[3]);
                    *(u32x4*)(Ob + (size_t)row * ldc + col) = w; } }
    }
};

template <int KIND> struct RetOrder {
    int G, c; const char* P; const char* B2; const char* A2; const char* KTF; const char* KTB;
    __device__ bool next(int i, Unit& u) const {
        const int L = i * G + c; const int nun = KIND == 1 ? 512 : 272; if (L >= nun) return false;
        u.pm = 0; u.pn = 0; u.z = L;
        if (KIND == 1) { const int pc = L & 15, dir = (L >> 4) & 1, bh = L >> 5; const int cc = dir ? (pc == 0 ? 0 : 17 - pc) : pc;
            u.a = B2 + (size_t)((bh * 17 + cc) * 256) * 768 * 2; u.b = (dir ? KTB : KTF) + ((size_t)(bh * 256) * ::SL + 256 * cc) * 2; }
        else if (KIND == 2) { const int b = L / 68, h = (L / 17) & 3, cc = L % 17; const size_t r0 = (size_t)::rowF(b, 256 * cc);
            u.a = P + (r0 * ::EIN + 1024 + h * 256) * 2; u.b = P + (r0 * ::EIN + 2048 + h * 256) * 2; }
        else { u.a = A2 + (size_t)L * 256 * 768 * 2; u.b = B2 + (size_t)L * 256 * 768 * 2; }
        return true;
    }
    __device__ __forceinline__ void a_ready(const Unit&) const {}
    __device__ __forceinline__ void done(const Unit&) const {}
};

struct CtxOrder {
    int G, c; const char* A; const char* B; int lda, ldb, nN, ksplit, Ksub;
    __device__ bool next(int i, Unit& u) const {
        const int L = i * G + c; if (L >= 4 * nN * ksplit) return false;
        const int ks = L % ksplit, t = L / ksplit; u.pn = t % nN; u.pm = t / nN; u.z = ks;
        u.a = A + ((size_t)u.pm * 256 * lda + (size_t)ks * Ksub) * 2; u.b = B + ((size_t)u.pn * 256 * ldb + (size_t)ks * Ksub) * 2; return true;
    }
    __device__ __forceinline__ void a_ready(const Unit&) const {}
    __device__ __forceinline__ void done(const Unit&) const {}
};
template <class Epi, class Sched, bool ALIGN_EPI = false, bool SP2 = false>
__device__ __forceinline__ void gemm_phase(PG8_LAS unsigned char* lds, const Gemm g, const Sched& S, const Epi& E, const int wid_s  ) {
    unsigned om_ = ~0u; asm volatile("" : "+s"(om_));
    const int tid0_ = wid_s * 64 + (int)__builtin_amdgcn_mbcnt_hi(om_, __builtin_amdgcn_mbcnt_lo(om_, 0u));
    const int tid = tid0_, wid = __builtin_amdgcn_readfirstlane(tid >> 6), lane = tid & 63, wr = wid >> 2, wc = wid & 3, fr = lane & 15, fq = lane >> 4;
    const int K = g.K, nt = K / BK;
    unsigned voffA[2], voffB[2];
#pragma unroll
    for (int i = 0; i < 2; ++i) { int R, C; stage_rc(tid * 16 + i * 8192, R, C); const int Rb = Epi::PERM ? ((R & ~31) + perm32(R & 31)) : R;
        voffA[i] = (unsigned)(R * g.lda + C) * 2u; voffB[i] = (unsigned)(Rb * g.ldb + C) * 2u; }
    const size_t kstep = (size_t)(BK * 2);
    const size_t hstepA = (size_t)HALF * g.lda * 2, hstepB = (size_t)HALF * g.ldb * 2;
    const unsigned ldsw = (unsigned)wid * 1024u;
    const int aoff = lds_byte(wr * 64 + fr, fq * 8), boff = lds_byte(wc * 32 + fr, fq * 8);
#define PG8_SA(b, h) (((b) * 2 + (h)) * HTB)
#define PG8_SB(b, h) ((4 + (b) * 2 + (h)) * HTB)
#define PG8_STAGE(bufoff, gbase, voff) do { _Pragma("unroll") for (int _i = 0; _i < 2; ++_i) \
        __builtin_amdgcn_global_load_lds((const unsigned*)((const char*)(gbase) + (voff)[_i]), (PG8_LAS unsigned*)(lds + (bufoff) + ldsw + _i * 8192), 16, 0, 0); } while (0)
#define PG8_LDA(dst, b, h) do { _Pragma("unroll") for (int m = 0; m < 4; ++m) _Pragma("unroll") for (int k = 0; k < 2; ++k) dst[m][k] = *(const PG8_LAS bf16x8*)(lds + PG8_SA(b, h) + aoff + m * 2048 + k * 1024); } while (0)
#define PG8_LDB(dst, b, h) do { _Pragma("unroll") for (int n = 0; n < 2; ++n) _Pragma("unroll") for (int k = 0; k < 2; ++k) dst[n][k] = *(const PG8_LAS bf16x8*)(lds + PG8_SB(b, h) + boff + n * 2048 + k * 1024); } while (0)
#define PG8_MMA(ai, bj, At, Bt) do { __builtin_amdgcn_s_setprio(1); _Pragma("unroll") for (int m = 0; m < 4; ++m) _Pragma("unroll") for (int n = 0; n < 2; ++n) _Pragma("unroll") for (int k = 0; k < 2; ++k) \
        acc[ai][bj][m][n] = __builtin_amdgcn_mfma_f32_16x16x32_bf16(Bt[n][k], At[m][k], acc[ai][bj][m][n], 0, 0, 0); __builtin_amdgcn_s_setprio(0); } while (0)
#define PG8_WAIT_V(n) asm volatile("s_waitcnt vmcnt(" #n ")" ::: "memory")
#define PG8_WAIT_L(n) asm volatile("s_waitcnt lgkmcnt(" #n ")" ::: "memory")
#define PG8_BAR __builtin_amdgcn_s_barrier()
#define PG8_SCHED __builtin_amdgcn_sched_barrier(0)
    Unit cur, nxt; int ui = 0;
    if (!S.next(0, cur)) return;
    f32x4 acc[2][2][4][2];
#pragma unroll
    for (int a = 0; a < 2; ++a)
#pragma unroll
        for (int b = 0; b < 2; ++b)
#pragma unroll
            for (int m = 0; m < 4; ++m)
#pragma unroll
                for (int n = 0; n < 2; ++n) acc[a][b][m][n] = (f32x4){0.f, 0.f, 0.f, 0.f};
    bf16x8 At[4][2], B0[2][2], B1[2][2];
    const char* cA = cur.a; const char* cB = cur.b;
    S.a_ready(cur);
    if constexpr (SP2) {
        PG8_STAGE(PG8_SB(0, 0), cB, voffB); PG8_STAGE(PG8_SB(0, 1), cB + hstepB, voffB); PG8_STAGE(PG8_SA(0, 0), cA, voffA); PG8_STAGE(PG8_SA(0, 1), cA + hstepA, voffA);
        if (wr == 1) PG8_BAR;
        PG8_WAIT_V(2); PG8_BAR;
        PG8_STAGE(PG8_SB(1, 0), cB + kstep, voffB); PG8_STAGE(PG8_SA(1, 0), cA + kstep, voffA); PG8_STAGE(PG8_SB(1, 1), cB + hstepB + kstep, voffB);
        PG8_WAIT_V(6); PG8_BAR;
    } else {
        PG8_STAGE(PG8_SB(0, 0), cB, voffB); PG8_STAGE(PG8_SA(0, 0), cA, voffA); PG8_STAGE(PG8_SB(0, 1), cB + hstepB, voffB); PG8_STAGE(PG8_SA(0, 1), cA + hstepA, voffA);
        if (wr == 1) PG8_BAR;
        PG8_WAIT_V(4); PG8_BAR;
        PG8_STAGE(PG8_SB(1, 0), cB + kstep, voffB); PG8_STAGE(PG8_SA(1, 0), cA + kstep, voffA); PG8_STAGE(PG8_SB(1, 1), cB + hstepB + kstep, voffB);
        PG8_WAIT_V(6); PG8_BAR;
    }
    for (;;) {
        const bool has_next = S.next(ui + 1, nxt);
        const char* nA = has_next ? nxt.a : cA; const char* nB = has_next ? nxt.b : cB;
        for (int t = 0; t < nt; t += 2) {
            const bool last = (t == nt - 2);
            const char* a1 = cA + (size_t)(t + 1) * kstep;
            const char* a2 = last ? nA : cA + (size_t)(t + 2) * kstep; const char* b2 = last ? nB : cB + (size_t)(t + 2) * kstep;
            const char* a3 = a2 + kstep; const char* b3 = b2 + kstep;
            if (last && has_next) S.a_ready(nxt);
            if constexpr (SP2) {
            PG8_LDB(B0, 0, 0); PG8_LDB(B1, 0, 1); PG8_SCHED; PG8_LDA(At, 0, 0); PG8_STAGE(PG8_SA(1, 1), a1 + hstepA, voffA);
            PG8_WAIT_V(8); PG8_WAIT_L(0); PG8_BAR; PG8_MMA(0, 0, At, B0); PG8_MMA(0, 1, At, B1); PG8_BAR; PG8_SCHED;
            PG8_LDA(At, 0, 1); PG8_STAGE(PG8_SB(0, 0), b2, voffB); PG8_STAGE(PG8_SB(0, 1), b2 + hstepB, voffB); PG8_STAGE(PG8_SA(0, 0), a2, voffA);
            PG8_WAIT_V(8); PG8_WAIT_L(0); PG8_BAR; PG8_MMA(1, 0, At, B0); PG8_MMA(1, 1, At, B1); PG8_BAR; PG8_SCHED;
            PG8_LDB(B0, 1, 0); PG8_LDB(B1, 1, 1); PG8_SCHED; PG8_LDA(At, 1, 0); PG8_STAGE(PG8_SA(0, 1), a2 + hstepA, voffA);
            PG8_WAIT_V(8); PG8_WAIT_L(0); PG8_BAR; PG8_MMA(0, 0, At, B0); PG8_MMA(0, 1, At, B1); PG8_BAR; PG8_SCHED;
            PG8_LDA(At, 1, 1); PG8_STAGE(PG8_SB(1, 0), b3, voffB); PG8_STAGE(PG8_SB(1, 1), b3 + hstepB, voffB); PG8_STAGE(PG8_SA(1, 0), a3, voffA);
            PG8_WAIT_V(8); PG8_WAIT_L(0); PG8_BAR; PG8_MMA(1, 0, At, B0); PG8_MMA(1, 1, At, B1); PG8_BAR; PG8_SCHED;
            } else {
            PG8_LDB(B0, 0, 0); PG8_SCHED; PG8_LDA(At, 0, 0); PG8_STAGE(PG8_SA(1, 1), a1 + hstepA, voffA);
            PG8_WAIT_L(8); PG8_BAR; PG8_WAIT_L(0); PG8_MMA(0, 0, At, B0); PG8_BAR; PG8_SCHED;
            PG8_LDB(B1, 0, 1); PG8_STAGE(PG8_SB(0, 0), b2, voffB);
            PG8_BAR; PG8_WAIT_L(0); PG8_MMA(0, 1, At, B1); PG8_BAR;
            PG8_LDA(At, 0, 1); PG8_STAGE(PG8_SA(0, 0), a2, voffA);
            PG8_BAR; PG8_WAIT_L(0); PG8_MMA(1, 0, At, B0); PG8_BAR; PG8_SCHED;
            PG8_STAGE(PG8_SB(0, 1), b2 + hstepB, voffB);
            PG8_WAIT_V(6); PG8_BAR; PG8_MMA(1, 1, At, B1); PG8_BAR;
            PG8_LDB(B0, 1, 0); PG8_SCHED; PG8_LDA(At, 1, 0); PG8_STAGE(PG8_SA(0, 1), a2 + hstepA, voffA);
            PG8_WAIT_L(8); PG8_BAR; PG8_WAIT_L(0); PG8_MMA(0, 0, At, B0); PG8_BAR; PG8_SCHED;
            PG8_LDB(B1, 1, 1); PG8_STAGE(PG8_SB(1, 0), b3, voffB);
            PG8_BAR; PG8_WAIT_L(0); PG8_MMA(0, 1, At, B1); PG8_BAR;
            PG8_LDA(At, 1, 1); PG8_STAGE(PG8_SA(1, 0), a3, voffA);
            PG8_BAR; PG8_WAIT_L(0); PG8_MMA(1, 0, At, B0); PG8_BAR; PG8_SCHED;
            PG8_STAGE(PG8_SB(1, 1), b3 + hstepB, voffB);
            PG8_WAIT_V(6); PG8_BAR; PG8_MMA(1, 1, At, B1); PG8_BAR;
            }
        }
        if constexpr (ALIGN_EPI) { if (wr == 0) PG8_BAR; }
        if constexpr (!Epi::AFTER_DRAIN) { E(acc, cur, wr, wc, fr, fq); S.done(cur); }
        if (!has_next) break;
#pragma unroll
        for (int a = 0; a < 2; ++a)
#pragma unroll
            for (int b = 0; b < 2; ++b)
#pragma unroll
                for (int m = 0; m < 4; ++m)
#pragma unroll
                    for (int n = 0; n < 2; ++n) acc[a][b][m][n] = (f32x4){0.f, 0.f, 0.f, 0.f};
        cur = nxt; cA = nA; cB = nB; ++ui;
        if constexpr (ALIGN_EPI) { if (wr == 1) PG8_BAR; }
    }
    PG8_WAIT_V(0);
    if constexpr (!ALIGN_EPI) { if (wr == 0) PG8_BAR; }
    PG8_BAR;
    if constexpr (Epi::AFTER_DRAIN) { E.fused(acc, cur, wr, wc, fr, fq, lds, wid, lane); S.done(cur); }
#undef PG8_SA
#undef PG8_SB
#undef PG8_STAGE
#undef PG8_LDA
#undef PG8_LDB
#undef PG8_MMA
#undef PG8_WAIT_V
#undef PG8_WAIT_L
#undef PG8_BAR
#undef PG8_SCHED
}
}
#define LAS __attribute__((address_space(3)))
typedef unsigned short bf16_t;
typedef short bf16x8 __attribute__((ext_vector_type(8)));
typedef float f32x4 __attribute__((ext_vector_type(4)));
typedef unsigned u32x4 __attribute__((ext_vector_type(4)));
typedef unsigned u32x2 __attribute__((ext_vector_type(2)));

__device__ __forceinline__ float bf2f(unsigned short h) { return __uint_as_float((unsigned)h << 16); }
__device__ __forceinline__ float bflo(unsigned w) { return __uint_as_float(w << 16); }
__device__ __forceinline__ float bfhi(unsigned w) { return __uint_as_float(w & 0xffff0000u); }
typedef float f32x2_t __attribute__((ext_vector_type(2))); typedef __bf16 bf16x2_t __attribute__((ext_vector_type(2)));
__device__ __forceinline__ unsigned pk2(float lo, float hi) { f32x2_t v = {lo, hi}; bf16x2_t b = __builtin_convertvector(v, bf16x2_t); return __builtin_bit_cast(unsigned, b); }
__device__ __forceinline__ unsigned short f2bf(float f) { return (unsigned short)(pk2(f, 0.f) & 0xffffu); }
__device__ __forceinline__ f32x4 mfma16(bf16x8 a, bf16x8 b, f32x4 c) { return __builtin_amdgcn_mfma_f32_16x16x32_bf16(a, b, c, 0, 0, 0); }
__device__ __forceinline__ bf16x8 ldfrag(const bf16_t* base, int ld, int r, int q) { return *(const bf16x8*)(base + (size_t)r * ld + 8 * q); }
__device__ __forceinline__ float wave_sum(float v) {
#pragma unroll
    for (int o = 1; o < 64; o <<= 1) v += __shfl_xor(v, o);
    return v;
}
#define LDS_WAIT() asm volatile("s_waitcnt lgkmcnt(0)" ::: "memory")
__device__ __forceinline__ bf16x8 scale_frag(bf16x8 v, float s) {
    u32x4 w = __builtin_bit_cast(u32x4, v); u32x4 o;
    o.x = pk2(bflo(w.x) * s, bfhi(w.x) * s); o.y = pk2(bflo(w.y) * s, bfhi(w.y) * s); o.z = pk2(bflo(w.z) * s, bfhi(w.z) * s); o.w = pk2(bflo(w.w) * s, bfhi(w.w) * s);
    return __builtin_bit_cast(bf16x8, o);
}

struct Args {
    const float *x, *c, *ctx, *c_ctx, *mod_w, *mod_b, *norm_g, *mlp_w1, *mlp_w2, *even_w_in, *even_w_out;
    const float *lam_re, *lam_im, *log_dt, *b_re, *b_im, *c_re, *c_im, *s5_d, *glu_w, *glu_b, *odd_w_in, *odd_w_out, *odd_sink;
    float* out; unsigned char* ws;
};

__device__ __forceinline__ void phase_mod(const Args& A, float* MOD, LAS float* ldsf, int tid, int wave, int lane, int bid, int G) {
    for (int i = tid; i < 5 * DM; i += 512) { const int r = i / DM, k = i % DM; const float v = r < 4 ? A.c[r * DM + k] : A.c_ctx[k]; ldsf[i] = v / (1.f + expf(-v)); }
    __syncthreads();
    LAS float* red = ldsf + 5 * DM;
    for (int it = bid; it < 512; it += G) {
        const int L = it / 256, cc = it % 256, col = cc * 48 + (lane < 48 ? lane : 47);
        const float* w = A.mod_w + (size_t)L * DM * 12288 + col;
        float a0 = 0.f, a1 = 0.f, a2 = 0.f, a3 = 0.f, a4 = 0.f;
        const int k0 = wave * 256;
#pragma unroll 32
        for (int k = k0; k < k0 + 256; ++k) { const float wv = w[(size_t)k * 12288]; a0 += ldsf[k] * wv; a1 += ldsf[DM + k] * wv; a2 += ldsf[2 * DM + k] * wv; a3 += ldsf[3 * DM + k] * wv; a4 += ldsf[4 * DM + k] * wv; }
        red[(wave * 5 + 0) * 64 + lane] = a0; red[(wave * 5 + 1) * 64 + lane] = a1; red[(wave * 5 + 2) * 64 + lane] = a2; red[(wave * 5 + 3) * 64 + lane] = a3; red[(wave * 5 + 4) * 64 + lane] = a4;
        __syncthreads();
        if (wave == 0 && lane < 48) {
            const float bias = A.mod_b[L * 12288 + col]; const int k6 = col / DM, cw = col % DM;
#pragma unroll
            for (int r = 0; r < 5; ++r) { float s = 0.f;
#pragma unroll
                for (int w8 = 0; w8 < 8; ++w8) s += red[(w8 * 5 + r) * 64 + lane];
                float v = s + bias;
                if (k6 == 1) v = (1.f + v) * A.norm_g[(L * 4 + 0) * DM + cw]; else if (k6 == 4) v = (1.f + v) * A.norm_g[(L * 4 + 2) * DM + cw];
                else if (k6 == 2) v = v * A.norm_g[(L * 4 + 1) * DM + cw]; else if (k6 == 5) v = v * A.norm_g[(L * 4 + 3) * DM + cw];
                MOD[((L * 6 + k6) * 5 + r) * DM + cw] = v; }
        }
        __syncthreads();
    }
}
__device__ __forceinline__ void p0_transpose_item(const float* W, int K, int N, bf16_t* WT, LAS float* scr, int item, int lane, bool perm = false) {
    const int nblk = N / 32, kb = item / nblk, nb = item % nblk, k0 = 64 * kb, n0 = 32 * nb;
    float wv[32];
#pragma unroll
    for (int i = 0; i < 32; ++i) { const int kk = 2 * i + (lane >> 5); wv[i] = W[(size_t)(k0 + kk) * N + n0 + (lane & 31)]; }
#pragma unroll
    for (int i = 0; i < 32; ++i) { const int kk = 2 * i + (lane >> 5); scr[kk * 33 + (lane & 31)] = wv[i]; }
    LDS_WAIT();
    const int c = lane & 7;
#pragma unroll
    for (int j = 0; j < 4; ++j) { const int n = (lane >> 3) + 8 * j; const LAS float* s = scr + (8 * c) * 33 + n;
        u32x4 o; o.x = pk2(s[0 * 33], s[1 * 33]); o.y = pk2(s[2 * 33], s[3 * 33]); o.z = pk2(s[4 * 33], s[5 * 33]); o.w = pk2(s[6 * 33], s[7 * 33]);
        int rn = n0 + n; if (perm && rn < 2304) rn = (rn & ~63) | ((rn & 31) << 1) | ((rn >> 5) & 1);
        *(u32x4*)(WT + (size_t)rn * K + k0 + 8 * c) = o; }
    LDS_WAIT();
}
__device__ __forceinline__ void phase_wconv(const Args& A, unsigned char* ws, LAS float* scr, int gw, int NGW, int lane) {
    constexpr int I0 = (DM / 64) * (EIN / 32), I1 = (1024 / 64) * (1024 / 32), I2 = (DM / 64) * (DM / 32), I3 = (DM / 64) * (FF / 32), I4 = (FF / 64) * (DM / 32), I5 = (DM / 64) * (OIN / 32);
    constexpr int NIT = I0 + I1 + I2 + 2 * I3 + 2 * I4 + I5 + I2;
    for (int it = gw; it < NIT; it += NGW) {
        int r = it;
        if (r < I0) { p0_transpose_item(A.even_w_in, DM, EIN, (bf16_t*)(ws + WS_WIN0), scr, r, lane); continue; } r -= I0;
        if (r < I1) { p0_transpose_item(A.glu_w, 1024, 1024, (bf16_t*)(ws + WS_GLU), scr, r, lane); continue; } r -= I1;
        if (r < I2) { p0_transpose_item(A.even_w_out, DM, DM, (bf16_t*)(ws + WS_WOUT0), scr, r, lane); continue; } r -= I2;
        if (r < I3) { p0_transpose_item(A.mlp_w1, DM, FF, (bf16_t*)(ws + WS_W1_0), scr, r, lane); continue; } r -= I3;
        if (r < I4) { p0_transpose_item(A.mlp_w2, FF, DM, (bf16_t*)(ws + WS_W2_0), scr, r, lane); continue; } r -= I4;
        if (r < I5) { p0_transpose_item(A.odd_w_in, DM, OIN, (bf16_t*)(ws + WS_WIN1), scr, r, lane, true); continue; } r -= I5;
        if (r < I2) { p0_transpose_item(A.odd_w_out, DM, DM, (bf16_t*)(ws + WS_WOUT1), scr, r, lane); continue; } r -= I2;
        if (r < I3) { p0_transpose_item(A.mlp_w1 + (size_t)DM * FF, DM, FF, (bf16_t*)(ws + WS_W1_1), scr, r, lane); continue; } r -= I3;
        p0_transpose_item(A.mlp_w2 + (size_t)DM * FF, FF, DM, (bf16_t*)(ws + WS_W2_1), scr, r, lane);
    }
}
__device__ __forceinline__ void row_pass(const float* xs, const bf16_t* orow, const float* gate, const float* gpost, float* xd,
                                         const float* gpre, const float* shift, const float* scale, bf16_t* hd, int lane, int nparts = 1, size_t pstride = 0) {
    f32x4 v[8];
#pragma unroll
    for (int j = 0; j < 8; ++j) v[j] = *(const f32x4*)(xs + 4 * lane + 256 * j);
    if (orow) {
        f32x4 o[8]; float ss = 0.f;
#pragma unroll
        for (int j = 0; j < 8; ++j) { const u32x2 w = *(const u32x2*)(orow + 4 * lane + 256 * j); o[j] = (f32x4){bflo(w.x), bfhi(w.x), bflo(w.y), bfhi(w.y)}; }
        for (int p = 1; p < nparts; ++p) {
#pragma unroll
            for (int j = 0; j < 8; ++j) { const u32x2 w = *(const u32x2*)(orow + (size_t)p * pstride + 4 * lane + 256 * j); o[j] = o[j] + (f32x4){bflo(w.x), bfhi(w.x), bflo(w.y), bfhi(w.y)}; } }
#pragma unroll
        for (int j = 0; j < 8; ++j) ss += (o[j].x * o[j].x + o[j].y * o[j].y) + (o[j].z * o[j].z + o[j].w * o[j].w);
        ss = wave_sum(ss); const float rinv = 1.0f / sqrtf(ss * (1.f / DM) + EPS);
#pragma unroll
        for (int j = 0; j < 8; ++j) { const f32x4 g = *(const f32x4*)(gate + 4 * lane + 256 * j); v[j] = v[j] + g * (o[j] * rinv); }
        if (xd) {
#pragma unroll
            for (int j = 0; j < 8; ++j) *(f32x4*)(xd + 4 * lane + 256 * j) = v[j]; }
    }
    if (hd) {
        float ss = 0.f;
#pragma unroll
        for (int j = 0; j < 8; ++j) ss += (v[j].x * v[j].x + v[j].y * v[j].y) + (v[j].z * v[j].z + v[j].w * v[j].w);
        ss = wave_sum(ss); const float rinv = 1.0f / sqrtf(ss * (1.f / DM) + EPS);
#pragma unroll
        for (int j = 0; j < 8; ++j) { const int col = 4 * lane + 256 * j; const f32x4 sh = *(const f32x4*)(shift + col), sc = *(const f32x4*)(scale + col);
            const f32x4 h = (v[j] * rinv) * sc + sh; u32x2 w; w.x = pk2(h.x, h.y); w.y = pk2(h.z, h.w); *(u32x2*)(hd + col) = w; }
    }
}
#define XB_TMO      128
#define XB_XCNT(j)  (256  + 64 * (j))
#define XB_XSUB(j)  (1280 + 64 * (j))
#define XB_XGEN(j)  (2304 + 64 * (j))
#define XB_TOP      3328
#define XB_TOPGEN   3392
#define XCD_BAR_WORDS 3456
#define XB_SPIN_CAP (1u << 18)

__device__ __forceinline__ unsigned xb_ld(unsigned* p)              { return __hip_atomic_load(p, __ATOMIC_RELAXED, __HIP_MEMORY_SCOPE_AGENT); }
__device__ __forceinline__ unsigned xb_add(unsigned* p, unsigned v) { return __hip_atomic_fetch_add(p, v, __ATOMIC_RELAXED, __HIP_MEMORY_SCOPE_AGENT); }
__device__ __forceinline__ unsigned xb_xcc_id() { return (unsigned)__builtin_amdgcn_s_getreg((3 << 11) | 20) & 0xFu; }
#define XB_SPIN(cond, bar) do { unsigned _sp = 0; while (cond) { __builtin_amdgcn_s_sleep(1); \
    if ((++_sp & 255u) == 0u) { if (xb_ld(&(bar)[XB_TMO])) break; if (_sp > XB_SPIN_CAP) { atomicAdd(&(bar)[XB_TMO], 1u); break; } } } } while (0)

struct XcdBarrier {
    unsigned* bar; unsigned x;
    volatile LAS unsigned* st;
};

__device__ __forceinline__ XcdBarrier xcd_barrier_post(unsigned* bar, volatile LAS unsigned* st) {
    XcdBarrier b; b.bar = bar; b.x = xb_xcc_id(); b.st = st;
    if (threadIdx.x == 0) (void)xb_add(&bar[XB_XCNT(b.x)], 1u);
    return b;
}
__device__ __forceinline__ void xcd_barrier_complete(unsigned* bar, unsigned x, unsigned& nloc, unsigned& nx) {
    const unsigned G = gridDim.x * gridDim.y * gridDim.z;
    unsigned sum, cnt, mine, sp = 0u;
    for (;;) {
        sum = 0u; cnt = 0u; mine = 0u;
#pragma unroll
        for (unsigned j = 0; j < 16; ++j) { const unsigned c = xb_ld(&bar[XB_XCNT(j)]); sum += c; cnt += (c > 0u) ? 1u : 0u; mine = (j == x) ? c : mine; }
        if (sum == G) break;
        __builtin_amdgcn_s_sleep(1);
        if ((++sp & 255u) == 0u) { if (xb_ld(&bar[XB_TMO])) break; if (sp > XB_SPIN_CAP) { atomicAdd(&bar[XB_TMO], 1u); break; } }
    }
    nloc = mine > 0u ? mine : 1u; nx = cnt > 0u ? cnt : 1u;
}

__device__ __forceinline__ void xcd_barrier(const XcdBarrier& b) {
    asm volatile("s_waitcnt vmcnt(0)" ::: "memory");
    __syncthreads();
    if (threadIdx.x == 0) {
        unsigned* bar = b.bar;
        __builtin_amdgcn_s_waitcnt(0);
        unsigned nloc = b.st[0], nx = b.st[1];
        if (nloc == 0u) { xcd_barrier_complete(bar, b.x, nloc, nx); b.st[0] = nloc; b.st[1] = nx; }
        const unsigned old = xb_add(&bar[XB_XSUB(b.x)], 1u);
        const unsigned gen = old / nloc;
        if (old + 1u == (gen + 1u) * nloc) {
            __builtin_amdgcn_fence(__ATOMIC_RELEASE, "agent");
            asm volatile("s_waitcnt vmcnt(0)" ::: "memory");
            const unsigned og = xb_add(&bar[XB_TOP], 1u);
            const unsigned tg = og / nx;
            if (og + 1u == (tg + 1u) * nx) xb_add(&bar[XB_TOPGEN], 1u);
            else XB_SPIN(xb_ld(&bar[XB_TOPGEN]) == tg, bar);
            __builtin_amdgcn_fence(__ATOMIC_ACQUIRE, "agent");
            xb_add(&bar[XB_XGEN(b.x)], 1u);
            asm volatile("s_waitcnt vmcnt(0)" ::: "memory");
        } else {
            XB_SPIN(xb_ld(&bar[XB_XGEN(b.x)]) == gen, bar);
            __builtin_amdgcn_fence(__ATOMIC_ACQUIRE, "agent");
            asm volatile("s_waitcnt vmcnt(0)" ::: "memory");
        }
    }
    __syncthreads();
}
__device__ __forceinline__ void tr_item(const bf16_t* src, int ld, int col0, int b, int s0, bf16_t* outbase, int opitch, int mode, float lg, LAS unsigned short* scr, int lane) {
#pragma unroll
    for (int it = 0; it < 8; ++it) { const int sr = it * 8 + (lane >> 3); const int row = rowF(b, s0 + sr);
        const u32x4 v = *(const u32x4*)(src + (size_t)row * ld + col0 + 8 * (lane & 7));
        LAS unsigned* p = (LAS unsigned*)(scr + sr * 66 + 8 * (lane & 7)); p[0] = v.x; p[1] = v.y; p[2] = v.z; p[3] = v.w; }
    LDS_WAIT();
#pragma unroll
    for (int it = 0; it < 8; ++it) { const int j = it * 8 + (lane >> 3), sc0 = 8 * (lane & 7); float f[8];
#pragma unroll
        for (int k = 0; k < 8; ++k) f[k] = bf2f(scr[(sc0 + k) * 66 + j]);
        if (mode) {
#pragma unroll
            for (int k = 0; k < 8; ++k) { const int i = (s0 + sc0 + k) & 255; const float e = mode == 1 ? (float)(255 - i) : (float)i; f[k] *= exp2f(e * lg); } }
        u32x4 o; o.x = pk2(f[0], f[1]); o.y = pk2(f[2], f[3]); o.z = pk2(f[4], f[5]); o.w = pk2(f[6], f[7]);
        *(u32x4*)(outbase + (size_t)j * opitch + sc0) = o; }
    LDS_WAIT();
}
constexpr int S5_NSEG = 4, S5_LSEG = SL / S5_NSEG;
template <bool EMIT>
__device__ __forceinline__ void s5_scan(const Args& A, int b, int g, int dir, int seg, const bf16_t* P, float* E, bf16_t* Y, LAS unsigned char* scr, int lane) {
    const int n = lane, r = lane & 15, q = lane >> 4;
    const int pg = dir * 64 + g;
    const float lr = fminf(A.lam_re[pg * 64 + n], -1e-4f), li = A.lam_im[pg * 64 + n], dt = expf(A.log_dt[pg]);
    const float zr = lr * dt, zi = li * dt, mag = expf(zr);
    float sn, cs; sincosf(zi, &sn, &cs);
    const float ar = mag * cs, ai = mag * sn, den = lr * lr + li * li, nr = ar - 1.f;
    const float fre = (nr * lr + ai * li) / den, fim = (ai * lr - nr * li) / den;
    LAS float* BU = (LAS float*)scr; LAS unsigned short* Sb = (LAS unsigned short*)(scr + 8448); LAS unsigned short* Bc = (LAS unsigned short*)scr;
    {
        const float* br = A.b_re + (size_t)(pg * 64 + n) * 16; const float* bi = A.b_im + (size_t)(pg * 64 + n) * 16;
#pragma unroll
        for (int p = 0; p < 16; ++p) { const float x = br[p], y = bi[p]; Bc[n * 16 + p] = f2bf(fre * x - fim * y); Bc[(64 + n) * 16 + p] = f2bf(fre * y + fim * x); }
    }
    LDS_WAIT();
    bf16x8 Bf[8];
    const bf16x8 zero8 = (bf16x8){0, 0, 0, 0, 0, 0, 0, 0};
#pragma unroll
    for (int jt = 0; jt < 8; ++jt) Bf[jt] = q < 2 ? *(const LAS bf16x8*)(Bc + (16 * jt + r) * 16 + 8 * q) : zero8;
    LDS_WAIT();
    bf16x8 Cf[4];
    if (EMIT) {
#pragma unroll
        for (int ks = 0; ks < 4; ++ks) { const int j0 = 32 * ks + 8 * q; const bool im = j0 >= 64; const float* cp = (im ? A.c_im : A.c_re) + (size_t)(pg * 16 + r) * 64 + (j0 & 63); const float sg = im ? -1.f : 1.f;
            const f32x4 c0 = *(const f32x4*)cp, c1 = *(const f32x4*)(cp + 4); u32x4 w; w.x = pk2(sg * c0.x, sg * c0.y); w.y = pk2(sg * c0.z, sg * c0.w); w.z = pk2(sg * c1.x, sg * c1.y); w.w = pk2(sg * c1.z, sg * c1.w);
            Cf[ks] = __builtin_bit_cast(bf16x8, w); }
    }
    float hr = 0.f, hi = 0.f;
    const int ubase = ((b * 64 + g) * 2 + dir) * S5_NSEG;
    if (EMIT && seg > 0) {
        float pr = 1.f, pi = 0.f, xr = ar, xi = ai; int e = S5_LSEG;
        while (e) { if (e & 1) { const float t = pr * xr - pi * xi; pi = pr * xi + pi * xr; pr = t; } const float t2 = xr * xr - xi * xi; xi = 2.f * xr * xi; xr = t2; e >>= 1; }
        for (int s2 = 0; s2 < seg; ++s2) { const float er = E[(size_t)(ubase + s2) * 128 + n], ei = E[(size_t)(ubase + s2) * 128 + 64 + n];
            const float t = pr * hr - pi * hi + er; hi = pr * hi + pi * hr + ei; hr = t; }
    }
    const int sbeg = seg * S5_LSEG;
#define S5_ROW(pos) (dir ? rowB(b, (pos)) : rowF(b, (pos)))
#define S5_LDU(scv) (q < 2 ? *(const bf16x8*)(P + (size_t)S5_ROW(sbeg + 16 * (scv) + r) * EIN + g * 16 + 8 * q) : zero8)
    constexpr int NGRP = S5_LSEG / 64;
    LAS unsigned short* Yst = (LAS unsigned short*)(scr + 12800);
    bf16x8 un[4];
#pragma unroll
    for (int j = 0; j < 4; ++j) un[j] = S5_LDU(j);
#pragma unroll 1
    for (int grp = 0; grp < NGRP; ++grp) {
        bf16x8 uf[4];
#pragma unroll
        for (int j = 0; j < 4; ++j) uf[j] = un[j];
        if (grp + 1 < NGRP) {
#pragma unroll
            for (int j = 0; j < 4; ++j) un[j] = S5_LDU(4 * (grp + 1) + j); }
#pragma unroll
        for (int j = 0; j < 4; ++j) {
#pragma unroll
            for (int jt = 0; jt < 8; ++jt) { const f32x4 D = mfma16(uf[j], Bf[jt], (f32x4){0.f, 0.f, 0.f, 0.f});
#pragma unroll
                for (int i = 0; i < 4; ++i) BU[(4 * q + i) * 132 + 16 * jt + r] = D[i]; }
            LDS_WAIT();
            float bur[16], bui[16];
#pragma unroll
            for (int tt = 0; tt < 16; ++tt) { bur[tt] = BU[tt * 132 + n]; bui[tt] = BU[tt * 132 + 64 + n]; }
            asm volatile("" : "+v"(bur[0]), "+v"(bur[1]), "+v"(bur[2]), "+v"(bur[3]), "+v"(bur[4]), "+v"(bur[5]), "+v"(bur[6]), "+v"(bur[7]), "+v"(bur[8]), "+v"(bur[9]), "+v"(bur[10]), "+v"(bur[11]), "+v"(bur[12]), "+v"(bur[13]), "+v"(bur[14]), "+v"(bur[15]));
            asm volatile("" : "+v"(bui[0]), "+v"(bui[1]), "+v"(bui[2]), "+v"(bui[3]), "+v"(bui[4]), "+v"(bui[5]), "+v"(bui[6]), "+v"(bui[7]), "+v"(bui[8]), "+v"(bui[9]), "+v"(bui[10]), "+v"(bui[11]), "+v"(bui[12]), "+v"(bui[13]), "+v"(bui[14]), "+v"(bui[15]));
#pragma unroll
            for (int tt = 0; tt < 16; ++tt) {
                const float nhr = ar * hr - ai * hi + bur[tt], nhi = ar * hi + ai * hr + bui[tt]; hr = nhr; hi = nhi;
                if (EMIT) { Sb[tt * 136 + n] = f2bf(hr); Sb[tt * 136 + 64 + n] = f2bf(hi); } }
            if (EMIT) {
                LDS_WAIT();
                f32x4 Yv = (f32x4){0.f, 0.f, 0.f, 0.f};
#pragma unroll
                for (int ks = 0; ks < 4; ++ks) Yv = mfma16(*(const LAS bf16x8*)(Sb + r * 136 + 32 * ks + 8 * q), Cf[ks], Yv);
                LAS unsigned short* yd = Yst + (16 * j + 4 * q) * 16 + r;
#pragma unroll
                for (int i = 0; i < 4; ++i) yd[i * 16] = f2bf(Yv[i]);
            }
            LDS_WAIT();
        }
        if (EMIT) {
#pragma unroll
            for (int k = 0; k < 2; ++k) { const int chn = lane + 64 * k, tok = chn >> 1, hf = chn & 1; const u32x4 v = *(const LAS u32x4*)(Yst + tok * 16 + 8 * hf);
                *(u32x4*)(Y + (size_t)S5_ROW(sbeg + 64 * grp + tok) * 1024 + g * 16 + 8 * hf) = v; }
            LDS_WAIT();
        }
    }
    if (!EMIT) { E[(size_t)(ubase + seg) * 128 + n] = hr; E[(size_t)(ubase + seg) * 128 + 64 + n] = hi; }
}
__device__ __forceinline__ float gelu_tanh(float x) { const float z = 0.7978845608028654f * (x + 0.044715f * x * x * x); const float t = 1.f - 2.f / (__expf(2.f * z) + 1.f); return 0.5f * x * (1.f + t); }
constexpr int ATT_KP = 72, ATT_VP = 552, ATT_KBYTES = 544 * ATT_KP * 2, ATT_VBYTES = 64 * ATT_VP * 2;
static_assert(ATT_KBYTES + ATT_VBYTES <= LDS_BYTES, "attention LDS");
__device__ __forceinline__ void attn_load(int b, int kvh, int n0, const bf16_t* P1, const bf16_t* VT1, u32x4 (&kr)[9], u32x4 (&vr)[9], int tid) {
    const bf16_t* Vb = VT1 + (size_t)((b * 4 + kvh) * 64) * SL;
#pragma unroll
    for (int it = 0; it < 9; ++it) { const int idx = tid + 512 * it;
        if (idx < 4352) {
            { const int row = idx >> 3, ch = idx & 7; int grow;
              if (row < CTXL) grow = NLAT + b * CTXL + row; else { int key = n0 - 128 + (row - CTXL); key = key < 0 ? 0 : (key > SEQ - 1 ? SEQ - 1 : key); grow = b * SEQ + key; }
              kr[it] = *(const u32x4*)(P1 + (size_t)grow * OIN + 2048 + kvh * 64 + 8 * ch); }
            { const int e = idx / 68, ch = idx % 68; const int spos = ch < 32 ? 8 * ch : 128 + n0 + 8 * (ch - 32);
              vr[it] = *(const u32x4*)(Vb + (size_t)e * SL + spos); }
        } }
}
__device__ __forceinline__ void attn_store(const u32x4 (&kr)[9], const u32x4 (&vr)[9], LAS unsigned char* lds, int tid) {
#pragma unroll
    for (int it = 0; it < 9; ++it) { const int idx = tid + 512 * it;
        if (idx < 4352) {
            { const int row = idx >> 3, ch = idx & 7; *(LAS u32x4*)(lds + row * (ATT_KP * 2) + ch * 16) = kr[it]; }
            { const int e = idx / 68, ch = idx % 68; *(LAS u32x4*)(lds + ATT_KBYTES + e * (ATT_VP * 2) + ch * 16) = vr[it]; }
        } }
}
__device__ __forceinline__ void attn_unit(int b, int h, int n0, const bf16_t* P1, const float* sink, bf16_t* AO, const LAS unsigned char* lds, int lane) {
    const int r = lane & 15, q = lane >> 4;
    bf16x8 Qb[2][2];
#pragma unroll
    for (int nt = 0; nt < 2; ++nt)
#pragma unroll
        for (int ks = 0; ks < 2; ++ks) Qb[nt][ks] = ldfrag(P1 + (size_t)(b * SEQ + n0 + 16 * nt) * OIN + h * 64 + 32 * ks, OIN, r, q);
    const float snk = sink[h];
    float mrun[2] = {snk, snk}, lpart[2] = {0.f, 0.f};
    f32x4 O[2][4];
#pragma unroll
    for (int nt = 0; nt < 2; ++nt)
#pragma unroll
        for (int et = 0; et < 4; ++et) O[nt][et] = (f32x4){0.f, 0.f, 0.f, 0.f};
    const LAS unsigned char* Kl = lds + r * (ATT_KP * 2) + q * 16;
    const LAS unsigned char* Vl = lds + ATT_KBYTES + r * (ATT_VP * 2) + q * 8;
#pragma unroll 1
    for (int pr = 0; pr < 17; ++pr) {
        const bool loc = pr >= 8;
        const int m0 = loc ? n0 - 128 + 32 * (pr - 8) : 32 * pr;
        bf16x8 Kf[2][2];
#pragma unroll
        for (int kt = 0; kt < 2; ++kt)
#pragma unroll
            for (int ks = 0; ks < 2; ++ks) Kf[kt][ks] = *(const LAS bf16x8*)(Kl + (pr * 32 + 16 * kt) * (ATT_KP * 2) + ks * 64);
        bf16x8 Vf[4];
#pragma unroll
        for (int et = 0; et < 4; ++et) { const LAS unsigned char* vr = Vl + (16 * et) * (ATT_VP * 2) + pr * 64; const u32x2 lo = *(const LAS u32x2*)vr, hi = *(const LAS u32x2*)(vr + 32);
            u32x4 aw; aw.x = lo.x; aw.y = lo.y; aw.z = hi.x; aw.w = hi.y; Vf[et] = __builtin_bit_cast(bf16x8, aw); }
#pragma unroll
        for (int nt = 0; nt < 2; ++nt) {
            f32x4 S[2];
#pragma unroll
            for (int kt = 0; kt < 2; ++kt) { S[kt] = mfma16(Kf[kt][0], Qb[nt][0], (f32x4){0.f, 0.f, 0.f, 0.f}); S[kt] = mfma16(Kf[kt][1], Qb[nt][1], S[kt]); }
            if (loc) { const int qn = n0 + 16 * nt + r;
#pragma unroll
                for (int kt = 0; kt < 2; ++kt)
#pragma unroll
                    for (int i = 0; i < 4; ++i) { const int key = m0 + 16 * kt + 4 * q + i; const int d = key - qn; const bool ok = (d <= 128) && (d >= -128) && (key >= 0) && (key < SEQ); S[kt][i] = ok ? S[kt][i] : -1e30f; } }
            float tm = fmaxf(fmaxf(fmaxf(S[0][0], S[0][1]), fmaxf(S[0][2], S[0][3])), fmaxf(fmaxf(S[1][0], S[1][1]), fmaxf(S[1][2], S[1][3])));
            tm = fmaxf(tm, __shfl_xor(tm, 16)); tm = fmaxf(tm, __shfl_xor(tm, 32));
            const float mn = fmaxf(mrun[nt], tm), f = __expf(mrun[nt] - mn); mrun[nt] = mn;
            float p[8]; float ps = 0.f;
#pragma unroll
            for (int kt = 0; kt < 2; ++kt)
#pragma unroll
                for (int i = 0; i < 4; ++i) { p[kt * 4 + i] = __expf(S[kt][i] - mn); ps += p[kt * 4 + i]; }
            lpart[nt] = lpart[nt] * f + ps;
            u32x4 pw; pw.x = pk2(p[0], p[1]); pw.y = pk2(p[2], p[3]); pw.z = pk2(p[4], p[5]); pw.w = pk2(p[6], p[7]);
            const bf16x8 pb = __builtin_bit_cast(bf16x8, pw);
#pragma unroll
            for (int et = 0; et < 4; ++et) { O[nt][et] = O[nt][et] * f; O[nt][et] = mfma16(Vf[et], pb, O[nt][et]); }
        }
    }
#pragma unroll
    for (int nt = 0; nt < 2; ++nt) {
        float l = lpart[nt]; l += __shfl_xor(l, 16); l += __shfl_xor(l, 32); l += __expf(snk - mrun[nt]);
        const float rl = 1.f / l; const int row = b * SEQ + n0 + 16 * nt + r;
#pragma unroll
        for (int et = 0; et < 4; ++et) { u32x2 w; w.x = pk2(O[nt][et][0] * rl, O[nt][et][1] * rl); w.y = pk2(O[nt][et][2] * rl, O[nt][et][3] * rl);
            *(u32x2*)(AO + (size_t)row * DM + h * 64 + 16 * et + 4 * q) = w; }
    }
}
__global__ void __launch_bounds__(512, 2) fwd_megakernel(Args A) {
    extern __shared__ __attribute__((aligned(16))) unsigned char lds_raw[];
    cg::grid_group grid = cg::this_grid();
    LAS unsigned char* lds = (LAS unsigned char*)lds_raw;
    const int bid = blockIdx.x, G = gridDim.x, NGW = G * 8, NGT = G * 512;
    const int wave0 = __builtin_amdgcn_readfirstlane((int)threadIdx.x >> 6);
#define PH() unsigned om_ = ~0u; asm volatile("" : "+s"(om_)); const int tid = wave0 * 64 + (int)__builtin_amdgcn_mbcnt_hi(om_, __builtin_amdgcn_mbcnt_lo(om_, 0u)), lane = tid & 63, wave = wave0, gw = bid * 8 + wave, gtid = bid * 512 + tid; \
    LAS unsigned char* wscr = lds + wave * 16384; (void)lane; (void)gw; (void)gtid; (void)wscr
    unsigned char* ws = A.ws;
    float* MOD = (float*)(ws + WS_MOD); float* ROPE = (float*)(ws + WS_ROPE); float* S5E = (float*)(ws + WS_S5E); float* XC = (float*)(ws + WS_XC);
    bf16_t* XN = (bf16_t*)(ws + WS_XN);
    bf16_t* P = (bf16_t*)(ws + WS_P); bf16_t* B2 = (bf16_t*)(ws + WS_B2); bf16_t* KTF = (bf16_t*)(ws + WS_KTF); bf16_t* KTB = (bf16_t*)(ws + WS_KTB); bf16_t* LOC = (bf16_t*)(ws + WS_LOC); bf16_t* A2 = (bf16_t*)(ws + WS_A2); bf16_t* ORET = (bf16_t*)(ws + WS_ORET);
    bf16_t* YF = (bf16_t*)(ws + WS_YF); bf16_t* YB = (bf16_t*)(ws + WS_YB); bf16_t* YG = (bf16_t*)(ws + WS_YG);
    bf16_t* O1 = (bf16_t*)(ws + WS_O1); bf16_t* HB = (bf16_t*)(ws + WS_HB); bf16_t* O2 = (bf16_t*)(ws + WS_O2); bf16_t* O1C = (bf16_t*)(ws + WS_O1C); bf16_t* O2C = (bf16_t*)(ws + WS_O2C);
    bf16_t* P1 = (bf16_t*)(ws + WS_P1); bf16_t* VT1 = (bf16_t*)(ws + WS_VT1); bf16_t* AO = (bf16_t*)(ws + WS_AO); bf16_t* O1B = (bf16_t*)(ws + WS_O1B);
    volatile LAS unsigned* xb_st = (volatile LAS unsigned*)(lds + 148992);
    if (threadIdx.x == 0) { xb_st[0] = 0u; xb_st[1] = 0u; }
    __syncthreads();
    const XcdBarrier xbar = xcd_barrier_post((unsigned*)(ws + WS_BAR), xb_st);
#define GSYNC_CG() do { asm volatile("s_waitcnt vmcnt(0) lgkmcnt(0)" ::: "memory"); grid.sync(); } while (0)
#define GSYNC() do { xcd_barrier(xbar); } while (0)
#ifdef PROBE_A
    unsigned long long pr_prev = __builtin_amdgcn_s_memrealtime(), pr_t0 = pr_prev, pr_a = 0, pr_b = 0;
#define STAMP(cls) do { const unsigned long long now_ = __builtin_amdgcn_s_memrealtime(); if ((cls) == PROBE_A) pr_a += now_ - pr_prev; if ((cls) == PROBE_B) pr_b += now_ - pr_prev; pr_prev = now_; } while (0)
#else
#define STAMP(cls) do { } while (0)
#endif
#define MODV(L, k6, r) (MOD + (((L) * 6 + (k6)) * 5 + (r)) * DM)
#define NG(L, k) (A.norm_g + ((L) * 4 + (k)) * DM)
#define GEMM(MODE, Aptr, Bptr, Mv, Nv, Kv, Optr, ldcv, lo, hi, scv, ygp, ldyv, biasp) do { \
        pg8::Gemm g_{(Kv), (Kv), (Kv)}; pg8::StaticOrder S_; S_.init((Aptr), (Bptr), (Mv), (Nv), (Kv), (Kv), G, bid); \
        pg8::EpiX<MODE> E_{(Optr), (ldcv), (lo), (hi), (scv), (ygp), (ldyv), (biasp), 0}; \
        pg8::gemm_phase<pg8::EpiX<MODE>, pg8::StaticOrder, true, true>(lds, g_, S_, E_, wave0); } while (0)
#define CGEMM(Aptr, Bptr, Kfull, Optr) do { \
        int kv_ = (Kfull) / 8; asm volatile("" : "+s"(kv_)); pg8::Gemm g_{kv_, (Kfull), (Kfull)}; pg8::CtxOrder S_{G, bid, (const char*)(Aptr), (const char*)(Bptr), (Kfull), (Kfull), 8, 8, (Kfull) / 8}; \
        pg8::EpiX<0> E_{(Optr), DM, 0, 0, 1.f, nullptr, 0, nullptr, (size_t)NCTX * DM}; \
        pg8::gemm_phase<pg8::EpiX<0>, pg8::CtxOrder, true, true>(lds, g_, S_, E_, wave0); } while (0)
#define RGEMM(KIND, MODE, Kv, ldav, ldbv, Optr, ldcv, zsv) do { \
        int kv_ = (Kv); asm volatile("" : "+s"(kv_)); pg8::Gemm g_{kv_, (ldav), (ldbv)}; pg8::RetOrder<KIND> S_{G, bid, (const char*)P, (const char*)B2, (const char*)A2, (const char*)KTF, (const char*)KTB}; \
        pg8::EpiX<MODE> E_{(Optr), (ldcv), 0, 0, 1.f, nullptr, 0, nullptr, (size_t)(zsv)}; \
        pg8::gemm_phase<pg8::EpiX<MODE>, pg8::RetOrder<KIND>, true, true>(lds, g_, S_, E_, wave0); } while (0)

    { PH();
    phase_mod(A, MOD, (LAS float*)lds, tid, wave, lane, bid, G);
    phase_wconv(A, ws, (LAS float*)wscr, gw, NGW, lane);
    for (int i = gtid; i < 1024; i += NGT) { const int pos = i >> 4, f = i & 15; const float inv = exp2f(-(float)f * (13.287712379549449f / 16.f)); float sn, cs; sincosf((float)pos * inv, &sn, &cs); ROPE[2 * i] = cs; ROPE[2 * i + 1] = sn; }
    }
    if (ws == nullptr) grid.sync();
    GSYNC(); STAMP(0);
    { PH();
    for (int row = gw; row < NTOK; row += NGW) { const int mr = row < NLAT ? row / SEQ : 4; const float* xs = row < NLAT ? A.x + (size_t)row * DM : A.ctx + (size_t)(row - NLAT) * DM;
        row_pass(xs, nullptr, nullptr, nullptr, nullptr, NG(0, 0), MODV(0, 0, mr), MODV(0, 1, mr), XN + (size_t)row * DM, lane); }
    }
    GSYNC(); STAMP(1);
    { PH();
    GEMM(0, XN, ws + WS_WIN0, NTOK, EIN, DM, P, EIN, 2048, 3072, 0.0625f, nullptr, 0, nullptr);
    }
    GSYNC(); STAMP(2);
    { PH();
    for (int it = gw; it < NB * 3 * 16 * 68; it += NGW) { int t = it; const int sc = t % 68; t /= 68; const int cb = t % 16; t /= 16; const int which = t % 3; const int b = t / 3; const int h = cb >> 2;
        const int s0 = 64 * sc;
        if (which == 0) tr_item(P, EIN, 3072 + 64 * cb, b, s0, B2 + ((size_t)(((b * 4 + h) * 17 + (s0 >> 8)) * 256 + (cb & 3) * 64)) * 768 + (s0 & 255), 768, 0, 0.f, (LAS unsigned short*)wscr, lane);
        else tr_item(P, EIN, 2048 + 64 * cb, b, s0, (which == 1 ? KTF : KTB) + (size_t)(b * 1024 + 64 * cb) * SL + s0, SL, which, which == 1 ? ret_lg2(h, 0) : ret_lg2(h, 1), (LAS unsigned short*)wscr, lane); }
    for (int vb = bid; vb < 256; vb += G) { const int seg = vb & 3, dir = (vb >> 2) & 1, b = (vb >> 3) & 3, g = (vb >> 5) * 8 + wave;
        s5_scan<false>(A, b, g, dir, seg, P, S5E, nullptr, wscr, lane); }
    }
    GSYNC(); STAMP(5);
    { PH();
    RGEMM(1, 0, 256, 768, SL, LOC, 256, 65536);
    }
    GSYNC(); STAMP(6);
    { PH();
    for (int i = gtid; i < 32 * 8192; i += NGT) { const int bhd = i >> 13, e8 = (i & 8191) * 8; const int bh = bhd >> 1, h = bh & 3, dir = bhd & 1; const int e = e8 >> 8, d = e8 & 255;
        const float gT = exp2f(256.f * ret_lg2(h, dir)); const bf16_t* src = LOC + (size_t)(bhd * 16) * 65536 + e8;
        float run[8] = {0.f, 0.f, 0.f, 0.f, 0.f, 0.f, 0.f, 0.f};
        for (int pc = 0; pc < 17; ++pc) { const int cc = dir ? (pc == 0 ? 0 : 17 - pc) : pc;
            u32x4 o; o.x = pk2(run[0], run[1]); o.y = pk2(run[2], run[3]); o.z = pk2(run[4], run[5]); o.w = pk2(run[6], run[7]);
            *(u32x4*)(B2 + ((size_t)((bh * 17 + cc) * 256 + e)) * 768 + 256 + 256 * dir + d) = o;
            if (pc < 16) { const u32x4 w = *(const u32x4*)(src + (size_t)pc * 65536);
                run[0] = gT * run[0] + bflo(w.x); run[1] = gT * run[1] + bfhi(w.x); run[2] = gT * run[2] + bflo(w.y); run[3] = gT * run[3] + bfhi(w.y);
                run[4] = gT * run[4] + bflo(w.z); run[5] = gT * run[5] + bfhi(w.z); run[6] = gT * run[6] + bflo(w.w); run[7] = gT * run[7] + bfhi(w.w); } } }
    for (int i = gtid; i < NTOK * 4 * 32; i += NGT) { const int d8 = (i & 31) * 8, h = (i >> 5) & 3, row = i >> 7; const int in = row & 255;
        const int b = row < NLAT ? row / SEQ : (row - NLAT) / CTXL, cc = row < NLAT ? 1 + ((row & (SEQ - 1)) >> 8) : 0;
        const u32x4 w = *(const u32x4*)(P + (size_t)row * EIN + 1024 + h * 256 + d8);
        const float sf = exp2f((float)(in + 1) * ret_lg2(h, 0)), sb = exp2f((float)(256 - in) * ret_lg2(h, 1));
        bf16_t* dst = A2 + ((size_t)(((b * 4 + h) * 17 + cc) * 256 + in)) * 768 + 256 + d8;
        u32x4 o; o.x = pk2(bflo(w.x) * sf, bfhi(w.x) * sf); o.y = pk2(bflo(w.y) * sf, bfhi(w.y) * sf); o.z = pk2(bflo(w.z) * sf, bfhi(w.z) * sf); o.w = pk2(bflo(w.w) * sf, bfhi(w.w) * sf);
        *(u32x4*)dst = o;
        o.x = pk2(bflo(w.x) * sb, bfhi(w.x) * sb); o.y = pk2(bflo(w.y) * sb, bfhi(w.y) * sb); o.z = pk2(bflo(w.z) * sb, bfhi(w.z) * sb); o.w = pk2(bflo(w.w) * sb, bfhi(w.w) * sb);
        *(u32x4*)(dst + 256) = o; }
    RGEMM(2, 3, 256, EIN, EIN, A2, 768, 256 * 768);
    }
    GSYNC(); STAMP(8);
    { PH();
    RGEMM(3, 4, 768, 768, 768, ORET, 1024, 0);
    }
    GSYNC(); STAMP(8);
    { PH();
    for (int it = gw; it < NTOK * 4; it += NGW) { const int h = it & 3, row = it >> 2;
        const u32x2 ow = *(const u32x2*)(ORET + (size_t)row * 1024 + h * 256 + 4 * lane); const float o0 = bflo(ow.x), o1 = bfhi(ow.x), o2 = bflo(ow.y), o3 = bfhi(ow.y);
        const float ss = wave_sum((o0 * o0 + o1 * o1) + (o2 * o2 + o3 * o3)); const float rinv = 1.0f / sqrtf(ss * (1.f / 256.f) + EPS);
        const u32x2 gw2 = *(const u32x2*)(P + (size_t)row * EIN + 4096 + h * 256 + 4 * lane); const float g0 = bflo(gw2.x), g1 = bfhi(gw2.x), g2 = bflo(gw2.y), g3 = bfhi(gw2.y);
        u32x2 w; w.x = pk2(o0 * rinv * (g0 / (1.f + __expf(-g0))), o1 * rinv * (g1 / (1.f + __expf(-g1)))); w.y = pk2(o2 * rinv * (g2 / (1.f + __expf(-g2))), o3 * rinv * (g3 / (1.f + __expf(-g3))));
        *(u32x2*)(XN + (size_t)row * DM + 1024 + h * 256 + 4 * lane) = w; }
    for (int vb = bid; vb < 256; vb += G) { const int seg = vb & 3, dir = (vb >> 2) & 1, b = (vb >> 3) & 3, g = (vb >> 5) * 8 + wave;
        s5_scan<true>(A, b, g, dir, seg, P, S5E, dir ? YB : YF, wscr, lane); }
    }
    GSYNC(); STAMP(9);
    { PH();
    for (int i = gtid; i < NTOK * 128; i += NGT) { const int row = i >> 7, col = (i & 127) * 8;
        const u32x4 a = *(const u32x4*)(YF + (size_t)row * 1024 + col), bq = *(const u32x4*)(YB + (size_t)row * 1024 + col), u = *(const u32x4*)(P + (size_t)row * EIN + col);
        const f32x4 d0 = *(const f32x4*)(A.s5_d + col), d1 = *(const f32x4*)(A.s5_d + col + 4);
        float v[8] = {bflo(a.x) + bflo(bq.x) + d0.x * bflo(u.x), bfhi(a.x) + bfhi(bq.x) + d0.y * bfhi(u.x), bflo(a.y) + bflo(bq.y) + d0.z * bflo(u.y), bfhi(a.y) + bfhi(bq.y) + d0.w * bfhi(u.y),
                      bflo(a.z) + bflo(bq.z) + d1.x * bflo(u.z), bfhi(a.z) + bfhi(bq.z) + d1.y * bfhi(u.z), bflo(a.w) + bflo(bq.w) + d1.z * bflo(u.w), bfhi(a.w) + bfhi(bq.w) + d1.w * bfhi(u.w)};
        u32x4 o; o.x = pk2(gelu_tanh(v[0]), gelu_tanh(v[1])); o.y = pk2(gelu_tanh(v[2]), gelu_tanh(v[3])); o.z = pk2(gelu_tanh(v[4]), gelu_tanh(v[5])); o.w = pk2(gelu_tanh(v[6]), gelu_tanh(v[7]));
        *(u32x4*)(YG + (size_t)row * 1024 + col) = o; }
    }
    GSYNC(); STAMP(9);
    { PH();
    GEMM(2, YG, ws + WS_GLU, NTOK, 1024, 1024, XN, DM, 0, 0, 1.f, YG, 1024, A.glu_b);
    }
    GSYNC(); STAMP(2);
    { PH();
    GEMM(0, XN, ws + WS_WOUT0, NLAT, DM, DM, O1, DM, 0, 0, 1.f, nullptr, 0, nullptr);
    CGEMM(XN + (size_t)NLAT * DM, ws + WS_WOUT0, DM, O1C);
    }
    GSYNC(); STAMP(2);
    { PH();
    for (int row = gw; row < NTOK; row += NGW) { const int mr = row < NLAT ? row / SEQ : 4; const float* xs = row < NLAT ? A.x + (size_t)row * DM : A.ctx + (size_t)(row - NLAT) * DM;
        float* xd = row < NLAT ? A.out + (size_t)row * DM : XC + (size_t)(row - NLAT) * DM;
        const bool cx = row >= NLAT;
        row_pass(xs, cx ? O1C + (size_t)(row - NLAT) * DM : O1 + (size_t)row * DM, MODV(0, 2, mr), NG(0, 1), xd, NG(0, 2), MODV(0, 3, mr), MODV(0, 4, mr), XN + (size_t)row * DM, lane, cx ? 8 : 1, (size_t)NCTX * DM); }
    }
    GSYNC(); STAMP(1);
    { PH();
    GEMM(1, XN, ws + WS_W1_0, NTOK, FF, DM, HB, FF, 0, 0, 1.f, nullptr, 0, nullptr);
    }
    GSYNC(); STAMP(2);
    { PH();
    GEMM(0, HB, ws + WS_W2_0, NLAT, DM, FF, O2, DM, 0, 0, 1.f, nullptr, 0, nullptr);
    CGEMM(HB + (size_t)NLAT * FF, ws + WS_W2_0, FF, O2C);
    }
    GSYNC(); STAMP(2);
    { PH();
    for (int row = gw; row < NTOK; row += NGW) { const int mr = row < NLAT ? row / SEQ : 4; float* xd = row < NLAT ? A.out + (size_t)row * DM : XC + (size_t)(row - NLAT) * DM;
        const bool cx = row >= NLAT;
        row_pass(xd, cx ? O2C + (size_t)(row - NLAT) * DM : O2 + (size_t)row * DM, MODV(0, 5, mr), NG(0, 3), xd, NG(1, 0), MODV(1, 0, mr), MODV(1, 1, mr), XN + (size_t)row * DM, lane, cx ? 8 : 1, (size_t)NCTX * DM); }
    }
    GSYNC(); STAMP(1);
    { PH();
    GEMM(5, XN, ws + WS_WIN1, NTOK, OIN, DM, P1, OIN, 0, 0, 1.f, nullptr, 0, ROPE);
    }
    GSYNC(); STAMP(2);
    { PH();
    for (int it = gw; it < NB * 4 * 68; it += NGW) { int t = it; const int sc = t % 68; t /= 68; const int cb = t % 4; const int b = t / 4;
        tr_item(P1, OIN, 2304 + 64 * cb, b, 64 * sc, VT1 + (size_t)(b * 256 + 64 * cb) * SL + 64 * sc, SL, 0, 0.f, (LAS unsigned short*)wscr, lane); }
    }
    GSYNC(); STAMP(4);
    { PH();
    { u32x4 kr[9], vr[9];
      if (bid < NB * 4 * 128) attn_load(bid / 512, (bid / 128) % 4, 32 * (bid % 128), P1, VT1, kr, vr, tid);
      for (int vb = bid; vb < NB * 4 * 128; vb += G) { const int qg = vb % 128; const int kvh = (vb / 128) % 4; const int b = vb / 512;
        attn_store(kr, vr, lds, tid);
        __syncthreads();
        { const int nb = vb + G; if (nb < NB * 4 * 128) attn_load(nb / 512, (nb / 128) % 4, 32 * (nb % 128), P1, VT1, kr, vr, tid); }
        attn_unit(b, kvh * 8 + wave, 32 * qg, P1, A.odd_sink, AO, lds, lane);
        __syncthreads(); } }
    }
    GSYNC(); STAMP(4);
    { PH();
    GEMM(0, AO, ws + WS_WOUT1, NLAT, DM, DM, O1B, DM, 0, 0, 1.f, nullptr, 0, nullptr);
    }
    GSYNC(); STAMP(2);
    { PH();
    for (int row = gw; row < NLAT; row += NGW) { const int mr = row / SEQ; float* xd = A.out + (size_t)row * DM;
        row_pass(xd, O1B + (size_t)row * DM, MODV(1, 2, mr), NG(1, 1), xd, NG(1, 2), MODV(1, 3, mr), MODV(1, 4, mr), XN + (size_t)row * DM, lane); }
    }
    GSYNC(); STAMP(1);
    { PH();
    GEMM(1, XN, ws + WS_W1_1, NLAT, FF, DM, HB, FF, 0, 0, 1.f, nullptr, 0, nullptr);
    }
    GSYNC(); STAMP(2);
    { PH();
    GEMM(0, HB, ws + WS_W2_1, NLAT, DM, FF, O2, DM, 0, 0, 1.f, nullptr, 0, nullptr);
    }
    GSYNC(); STAMP(2);
    { PH();
    for (int row = gw; row < NLAT; row += NGW) { const int mr = row / SEQ; float* xd = A.out + (size_t)row * DM;
        row_pass(xd, O2 + (size_t)row * DM, MODV(1, 5, mr), NG(1, 3), xd, nullptr, nullptr, nullptr, nullptr, lane); }
    }
#ifdef PROBE_SYNC
    for (int i_ = 0; i_ < 40; ++i_) GSYNC();
#endif
#ifdef PROBE_A
    GSYNC(); STAMP(1);
    { PH(); unsigned long long* lk = (unsigned long long*)(ws + WS_S5E);
      if (bid == 0 && tid == 0) { lk[0] = pr_a; lk[1] = pr_prev - pr_t0; const unsigned long long t1 = __builtin_amdgcn_s_memrealtime(); while (__builtin_amdgcn_s_memrealtime() - t1 < 4ull * pr_b) __builtin_amdgcn_s_sleep(8); }
      GSYNC();
      const double fr = (double)lk[0] / (double)lk[1]; const int K = (int)(fr * 2000000.0);
      for (int i = gtid; i < K; i += NGT) A.out[(size_t)i * 16 + 5] += 0.05f; }
#endif
}

extern "C" void kernel_launch(void* const* d_in, const int* in_sizes, int n_in, void* d_out, int out_size, void* d_ws, size_t ws_size, hipStream_t stream) {
    static int grid = 0;
    if (grid == 0) {
        if (n_in != 24 || ws_size < WS_END) { fprintf(stderr, "kernel_launch: unexpected n_in %d / ws_size %zu (need %zu)\n", n_in, ws_size, (size_t)WS_END); grid = -1; return; }
        int dev = 0, cus = 0, per_cu = 0;
        (void)hipGetDevice(&dev); (void)hipDeviceGetAttribute(&cus, hipDeviceAttributeMultiprocessorCount, dev);
        (void)hipFuncSetAttribute((const void*)fwd_megakernel, hipFuncAttributeMaxDynamicSharedMemorySize, LDS_BYTES);
        if (hipOccupancyMaxActiveBlocksPerMultiprocessor(&per_cu, (const void*)fwd_megakernel, 512, LDS_BYTES) != hipSuccess || per_cu < 1) per_cu = 1;
        (void)hipGetLastError();
        grid = cus * 1;
    }
    if (grid < 0) return;
    (void)hipMemsetAsync((unsigned char*)d_ws + WS_BAR, 0, 16384, stream);
    Args a{};
    const float** f = (const float**)&a;
    for (int i = 0; i < 24; ++i) f[i] = (const float*)d_in[i];
    a.out = (float*)d_out; a.ws = (unsigned char*)d_ws;
    void* args[] = {&a};
    hipError_t e = hipLaunchCooperativeKernel((const void*)fwd_megakernel, dim3(grid), dim3(512), args, LDS_BYTES, stream);
    if (e != hipSuccess) fprintf(stderr, "cooperative launch failed: %s (grid %d)\n", hipGetErrorString(e), grid);
}
```
